# Optimizing an MI355X kernel written in HIP

```python
import jax, jax.numpy as jnp
from jax import lax
import numpy as np

D_MODEL = 1024
BATCH = 4
SEQ = 8192
DEPTH = 2

HEAD_DIM = 64
H_GDN = (3 * D_MODEL) // (8 * HEAD_DIM)
H_MOBA = D_MODEL // (4 * HEAD_DIM)
H_MLSTM = D_MODEL // HEAD_DIM - H_GDN - H_MOBA
W_GDN = H_GDN * HEAD_DIM
W_MOBA = H_MOBA * HEAD_DIM
W_MLSTM = H_MLSTM * HEAD_DIM
MIX_WIDTH = W_GDN + W_MOBA + W_MLSTM
CONV_WIDTH = 4
GDN_CHUNK = 64
MLSTM_CHUNK = 64
MOBA_BLOCK = 256
MOBA_TOPK = 3
MOBA_Q_BLOCK = 128
D_FF = 2816
N_SUB = 3
ALPHA = (2 * DEPTH) ** 0.25
BETA_INIT = (8 * DEPTH) ** -0.25
ADA_INIT = 0.1
LN_EPS = 1e-5
NORM_EPS = 1e-6

IN_SIZES = [3 * W_GDN, H_GDN, H_GDN, W_GDN,
            3 * W_MOBA,
            2 * W_MLSTM, W_MLSTM, H_MLSTM, H_MLSTM, W_MLSTM]
IN_SPLITS = [int(s) for s in np.cumsum(IN_SIZES)[:-1]]
D_IN = int(sum(IN_SIZES))

kernel_name = "hymba_gdn_moba_mlstm_macaron_deepnorm"


def layer_norm(x, g, b):
    xf = x.astype(jnp.float32)
    mu = jnp.mean(xf, -1, keepdims=True)
    var = jnp.mean(jnp.square(xf - mu), -1, keepdims=True)
    return ((xf - mu) * lax.rsqrt(var + LN_EPS) * g + b).astype(x.dtype)


def modulate(x, shift, scale):
    return x * (1 + scale[:, None, :]) + shift[:, None, :]


def swiglu(h, w13, w2):
    a, b = jnp.split(h @ w13, 2, axis=-1)
    return (jax.nn.silu(a) * b) @ w2


def causal_conv_silu(x, w):
    y = lax.conv_general_dilated(x, w[:, None, :], window_strides=(1,), padding=[(CONV_WIDTH - 1, 0)],
                                 dimension_numbers=('NWC', 'WIO', 'NWC'), feature_group_count=x.shape[-1])
    return jax.nn.silu(y)


def split_heads(t):
    b_, t_, w = t.shape
    return t.reshape(b_, t_, w // HEAD_DIM, HEAD_DIM).transpose(0, 2, 1, 3)


def l2norm(x):
    return x * lax.rsqrt(jnp.sum(x * x, -1, keepdims=True) + NORM_EPS)


def to_chunks(a, size):
    b_, h_, t_ = a.shape[:3]
    return jnp.moveaxis(a.reshape(b_, h_, t_ // size, size, *a.shape[3:]), 2, 0)


def from_chunks(a):
    n, b_, h_, l, d = a.shape
    return jnp.moveaxis(a, 0, 2).reshape(b_, h_, n * l, d)


def gated_delta_rule(q, k, v, g, beta):
    b_, h_, t_, dk = q.shape
    dv = v.shape[-1]
    L = GDN_CHUNK
    q = to_chunks(q * dk ** -0.5, L); k = to_chunks(k, L); v = to_chunks(v, L)
    g = to_chunks(g, L); beta = to_chunks(beta, L)
    G = jnp.cumsum(g, axis=-1)
    incl = jnp.tril(jnp.ones((L, L), dtype=bool))
    strict = jnp.tril(jnp.ones((L, L), dtype=bool), -1)
    decay = jnp.exp(jnp.where(incl, G[..., :, None] - G[..., None, :], -jnp.inf))
    kb = k * beta[..., None]
    A = jnp.where(strict, jnp.einsum('nbhid,nbhjd->nbhij', kb, k) * decay, 0.0)
    M = A + jnp.eye(L, dtype=A.dtype)
    u = lax.linalg.triangular_solve(M, v * beta[..., None], left_side=True, lower=True, unit_diagonal=True)
    w = lax.linalg.triangular_solve(M, kb * jnp.exp(G)[..., None], left_side=True, lower=True, unit_diagonal=True)
    attn = jnp.einsum('nbhid,nbhjd->nbhij', q, k) * decay
    q_dec = q * jnp.exp(G)[..., None]
    k_dec = k * jnp.exp(G[..., -1:] - G)[..., None]
    g_last = jnp.exp(G[..., -1])

    def step(S, inp):
        q_i, w_i, u_i, k_i, a_i, gl_i = inp
        v_new = u_i - jnp.einsum('bhld,bhde->bhle', w_i, S)
        o = jnp.einsum('bhld,bhde->bhle', q_i, S) + jnp.einsum('bhls,bhse->bhle', a_i, v_new)
        S = S * gl_i[..., None, None] + jnp.einsum('bhld,bhle->bhde', k_i, v_new)
        return S, o

    S0 = jnp.zeros((b_, h_, dk, dv), q.dtype)
    _, o = lax.scan(step, S0, (q_dec, w, u, k_dec, attn, g_last))
    return from_chunks(o)


def moba_attention(q, k, v):
    b_, h_, t_, d = q.shape
    n_blk = -(-t_ // MOBA_BLOCK)
    top_k = min(MOBA_TOPK, n_blk)
    pad = n_blk * MOBA_BLOCK - t_
    kp = jnp.pad(k, ((0, 0), (0, 0), (0, pad), (0, 0)))
    vp = jnp.pad(v, ((0, 0), (0, 0), (0, pad), (0, 0)))
    k_blk = kp.reshape(b_, h_, n_blk, MOBA_BLOCK, d)
    v_blk = vp.reshape(b_, h_, n_blk, MOBA_BLOCK, d)
    k_mean = jnp.mean(k_blk, axis=3)
    scale = d ** -0.5
    bi = jnp.arange(b_)[:, None, None, None]
    hi = jnp.arange(h_)[None, :, None, None]
    blk_ids = jnp.arange(n_blk)
    n_sel = top_k * MOBA_BLOCK

    def one_block(qb):
        q0 = qb * MOBA_Q_BLOCK
        own = q0 // MOBA_BLOCK
        qc = lax.dynamic_slice_in_dim(q, q0, MOBA_Q_BLOCK, axis=2)
        gate = jnp.einsum('bhqd,bhnd->bhqn', qc, k_mean)
        gate = jnp.where(blk_ids < own, gate, -jnp.inf)
        _, sel = lax.top_k(gate, top_k)
        sel_ok = jnp.repeat(jnp.arange(top_k) < own, MOBA_BLOCK)
        k_sel = k_blk[bi, hi, sel].reshape(b_, h_, MOBA_Q_BLOCK, n_sel, d)
        v_sel = v_blk[bi, hi, sel].reshape(b_, h_, MOBA_Q_BLOCK, n_sel, d)
        s_sel = jnp.where(sel_ok, jnp.einsum('bhqd,bhqkd->bhqk', qc, k_sel) * scale, -jnp.inf)
        k_own = lax.dynamic_slice_in_dim(kp, own * MOBA_BLOCK, MOBA_BLOCK, axis=2)
        v_own = lax.dynamic_slice_in_dim(vp, own * MOBA_BLOCK, MOBA_BLOCK, axis=2)
        q_pos = q0 + jnp.arange(MOBA_Q_BLOCK)
        k_pos = own * MOBA_BLOCK + jnp.arange(MOBA_BLOCK)
        s_own = jnp.where(k_pos[None, :] <= q_pos[:, None],
                          jnp.einsum('bhqd,bhkd->bhqk', qc, k_own) * scale, -jnp.inf)
        p = jax.nn.softmax(jnp.concatenate([s_sel, s_own], -1).astype(jnp.float32), axis=-1).astype(q.dtype)
        return (jnp.einsum('bhqk,bhqkd->bhqd', p[..., :n_sel], v_sel)
                + jnp.einsum('bhqk,bhkd->bhqd', p[..., n_sel:], v_own))

    out = lax.map(one_block, jnp.arange(t_ // MOBA_Q_BLOCK))
    return from_chunks(out)


def mlstm_chunkwise(q, k, v, i_pre, logf):
    b_, h_, t_, d = q.shape
    L = MLSTM_CHUNK
    q = to_chunks(q, L); k = to_chunks(k * d ** -0.5, L); v = to_chunks(v, L)
    i_pre = to_chunks(i_pre, L); logf = to_chunks(logf, L)
    bcum = jnp.cumsum(logf, axis=-1)
    incl = jnp.tril(jnp.ones((L, L), dtype=bool))
    D = jnp.where(incl, bcum[..., :, None] - bcum[..., None, :] + i_pre[..., None, :], -jnp.inf)
    D_max = jnp.max(D, axis=-1)
    w_end = bcum[..., -1:] - bcum + i_pre
    qk = jnp.einsum('nbhtd,nbhsd->nbhts', q, k)

    def step(carry, inp):
        C, n, m = carry
        q_i, k_i, v_i, b_i, D_i, Dm_i, qk_i, we_i = inp
        inter = b_i + m[..., None]
        m_t = jnp.maximum(inter, Dm_i)
        a_inter = jnp.exp(inter - m_t)
        P = qk_i * jnp.exp(D_i - m_t[..., None])
        num = a_inter[..., None] * jnp.einsum('bhld,bhde->bhle', q_i, C) + jnp.einsum('bhls,bhse->bhle', P, v_i)
        den = a_inter * jnp.einsum('bhld,bhd->bhl', q_i, n) + jnp.sum(P, -1)
        h = num / jnp.maximum(jnp.abs(den), jnp.exp(-m_t))[..., None]
        inter_end = b_i[..., -1] + m
        m_new = jnp.maximum(inter_end, jnp.max(we_i, -1))
        s = jnp.exp(we_i - m_new[..., None])
        decay = jnp.exp(inter_end - m_new)
        C = decay[..., None, None] * C + jnp.einsum('bhl,bhld,bhle->bhde', s, k_i, v_i)
        n = decay[..., None] * n + jnp.einsum('bhl,bhld->bhd', s, k_i)
        return (C, n, m_new), h

    init = (jnp.zeros((b_, h_, d, d), q.dtype), jnp.zeros((b_, h_, d), q.dtype), jnp.zeros((b_, h_), q.dtype))
    _, h = lax.scan(step, init, (q, k, v, bcum, D, D_max, qk, w_end))
    return from_chunks(h)


def token_mixer(h, w_in, w_out, gdn_conv, gdn_a_log, gdn_dt_bias, gdn_norm,
                mlstm_conv, mlstm_i_bias, mlstm_f_bias, mlstm_norm):
    b_, t_, _ = h.shape
    dt = h.dtype
    f32 = jnp.float32
    qkv_a, a_a, b_a, z_a, qkv_b, qk_c, v_c, i_c, f_c, o_c = jnp.split(h @ w_in, IN_SPLITS, axis=-1)
    qa, ka, va = jnp.split(causal_conv_silu(qkv_a, gdn_conv), 3, axis=-1)
    qa = l2norm(split_heads(qa).astype(f32))
    ka = l2norm(split_heads(ka).astype(f32))
    va = split_heads(va).astype(f32)
    g = -jnp.exp(gdn_a_log.astype(f32)) * jax.nn.softplus((a_a + gdn_dt_bias).astype(f32))
    beta = jax.nn.sigmoid(b_a.astype(f32))
    oa = gated_delta_rule(qa, ka, va, g.transpose(0, 2, 1), beta.transpose(0, 2, 1)).transpose(0, 2, 1, 3)
    oa = oa * lax.rsqrt(jnp.mean(oa * oa, -1, keepdims=True) + NORM_EPS) * gdn_norm
    oa = (oa.reshape(b_, t_, W_GDN) * jax.nn.silu(z_a.astype(f32))).astype(dt)
    qb, kb, vb = jnp.split(qkv_b, 3, axis=-1)
    ob = moba_attention(split_heads(qb), split_heads(kb), split_heads(vb))
    ob = ob.transpose(0, 2, 1, 3).reshape(b_, t_, W_MOBA).astype(dt)
    qc, kc = jnp.split(causal_conv_silu(qk_c, mlstm_conv), 2, axis=-1)
    i_pre = (i_c + mlstm_i_bias).astype(f32).transpose(0, 2, 1)
    logf = jax.nn.log_sigmoid((f_c + mlstm_f_bias).astype(f32)).transpose(0, 2, 1)
    hc = mlstm_chunkwise(split_heads(qc).astype(f32), split_heads(kc).astype(f32),
                         split_heads(v_c).astype(f32), i_pre, logf).transpose(0, 2, 1, 3)
    hc = hc * jax.nn.sigmoid(o_c.astype(f32)).reshape(b_, t_, H_MLSTM, HEAD_DIM)
    mu = jnp.mean(hc, -1, keepdims=True)
    var = jnp.mean(jnp.square(hc - mu), -1, keepdims=True)
    hc = (hc - mu) * lax.rsqrt(var + NORM_EPS) * mlstm_norm.reshape(H_MLSTM, HEAD_DIM)
    hc = hc.reshape(b_, t_, W_MLSTM).astype(dt)
    return jnp.concatenate([oa, ob, hc], axis=-1) @ w_out


def setup_inputs(seed: int = 0) -> dict:
    key = jax.random.key(seed)
    ks = jax.random.split(key, 18)
    nrm = lambda k, shape, s: jax.random.normal(k, shape, jnp.float32) * s
    dt_init = jnp.exp(jax.random.uniform(ks[10], (DEPTH, H_GDN), jnp.float32,
                                         float(np.log(1e-3)), float(np.log(1e-1))))
    return {
        "x": nrm(ks[0], (BATCH, SEQ, D_MODEL), 1.0),
        "c": nrm(ks[1], (BATCH, D_MODEL), 1.0),
        "ada_w": nrm(ks[2], (DEPTH, D_MODEL, N_SUB * 3 * D_MODEL), ADA_INIT * D_MODEL ** -0.5),
        "ada_b": nrm(ks[3], (DEPTH, N_SUB * 3 * D_MODEL), 0.01),
        "ffn_w13": nrm(ks[4], (DEPTH, 2, D_MODEL, 2 * D_FF), D_MODEL ** -0.5),
        "ffn_w2": nrm(ks[5], (DEPTH, 2, D_FF, D_MODEL), BETA_INIT * D_FF ** -0.5),
        "w_in": nrm(ks[6], (DEPTH, D_MODEL, D_IN), D_MODEL ** -0.5),
        "w_out": nrm(ks[7], (DEPTH, MIX_WIDTH, D_MODEL), BETA_INIT * MIX_WIDTH ** -0.5),
        "gdn_conv": nrm(ks[8], (DEPTH, CONV_WIDTH, 3 * W_GDN), CONV_WIDTH ** -0.5),
        "gdn_a_log": jnp.log(jax.random.uniform(ks[9], (DEPTH, H_GDN), jnp.float32, 1.0, 16.0)),
        "gdn_dt_bias": dt_init + jnp.log(-jnp.expm1(-dt_init)),
        "gdn_norm": 1.0 + nrm(ks[11], (DEPTH, HEAD_DIM), 0.02),
        "mlstm_conv": nrm(ks[12], (DEPTH, CONV_WIDTH, 2 * W_MLSTM), CONV_WIDTH ** -0.5),
        "mlstm_i_bias": nrm(ks[13], (DEPTH, H_MLSTM), 0.1),
        "mlstm_f_bias": jnp.linspace(3.0, 6.0, H_MLSTM, dtype=jnp.float32)[None, :] + nrm(ks[14], (DEPTH, H_MLSTM), 0.1),
        "mlstm_norm": 1.0 + nrm(ks[15], (DEPTH, W_MLSTM), 0.02),
        "ln_g": 1.0 + nrm(ks[16], (DEPTH, N_SUB, D_MODEL), 0.02),
        "ln_b": nrm(ks[17], (DEPTH, N_SUB, D_MODEL), 0.02),
    }


def reference(x, c, ada_w, ada_b, ffn_w13, ffn_w2, w_in, w_out, gdn_conv, gdn_a_log, gdn_dt_bias,
              gdn_norm, mlstm_conv, mlstm_i_bias, mlstm_f_bias, mlstm_norm, ln_g, ln_b):
    b_ = x.shape[0]
    for l in range(DEPTH):
        mod = (jax.nn.silu(c) @ ada_w[l] + ada_b[l]).reshape(b_, N_SUB, 3, D_MODEL)
        y = swiglu(modulate(x, mod[:, 0, 0], mod[:, 0, 1]), ffn_w13[l, 0], ffn_w2[l, 0])
        x = layer_norm(ALPHA * x + 0.5 * (1 + mod[:, 0, 2])[:, None, :] * y, ln_g[l, 0], ln_b[l, 0])
        y = token_mixer(modulate(x, mod[:, 1, 0], mod[:, 1, 1]), w_in[l], w_out[l], gdn_conv[l], gdn_a_log[l],
                        gdn_dt_bias[l], gdn_norm[l], mlstm_conv[l], mlstm_i_bias[l], mlstm_f_bias[l], mlstm_norm[l])
        x = layer_norm(ALPHA * x + (1 + mod[:, 1, 2])[:, None, :] * y, ln_g[l, 1], ln_b[l, 1])
        y = swiglu(modulate(x, mod[:, 2, 0], mod[:, 2, 1]), ffn_w13[l, 1], ffn_w2[l, 1])
        x = layer_norm(ALPHA * x + 0.5 * (1 + mod[:, 2, 2])[:, None, :] * y, ln_g[l, 2], ln_b[l, 2])
    return x
```

```cpp
#include <hip/hip_runtime.h>
#include <hip/hip_cooperative_groups.h>
#include <cstdio>
namespace cg = cooperative_groups;

typedef unsigned short u16;
using bf16x8 = __attribute__((ext_vector_type(8))) short;
using f32x4  = __attribute__((ext_vector_type(4))) float;
using u32x4  = __attribute__((ext_vector_type(4))) unsigned;

#define NTOK 32768
#define SEQ 8192
#define DM 1024
#define DFF 2816
#define PROJ_LD 3200
#define NT 256
#define SMEM_BYTES 73728
#define ALPHA_F 1.4142135623730951f

#define MiB (1024ull*1024ull)
#define OFF_PROJ   (0ull)
#define OFF_GDNI   (200ull*MiB)
#define OFF_MLI    (320ull*MiB)
#define OFF_WT     (396ull*MiB)
#define OFF_VCT    (439ull*MiB)
#define OFF_VBT    (463ull*MiB)
#define OFF_GATES  (479ull*MiB)
#define OFF_MODP   (482ull*MiB)
#define OFF_MOD    (484ull*MiB + 512*1024)
#define OFF_KMEAN  (485ull*MiB)
#define OFF_MCH    (485ull*MiB + 256*1024)
#define OFF_GL     (485ull*MiB + 320*1024)
#define OFF_CTR    (485ull*MiB + 384*1024)
#define OFF_XBAR   (485ull*MiB + 512*1024)
#define OFF_UH     (486ull*MiB)
#define OFF_UL     (487ull*MiB)
#define OFF_GM     (488ull*MiB)
#define OFF_ALO    OFF_MLI
#define WS_NEEDED  (504ull*MiB)

#define GDNI_STRIDE 20480
#define MLI_STRIDE  25856

#define WT13_OFF(f) ((size_t)(f)*5632*1024)
#define WT2_OFF(f)  ((size_t)2*5632*1024 + (size_t)(f)*1024*2816)
#define WTIN_OFF    ((size_t)2*5632*1024 + (size_t)2*1024*2816)
#define WTOUT_OFF   (WTIN_OFF + (size_t)3968*1024)

struct Params {
  const float *x, *c, *ada_w, *ada_b, *w13, *w2, *w_in, *w_out, *gdn_conv, *gdn_a_log, *gdn_dt_bias, *gdn_norm,
              *mlstm_conv, *mlstm_i_bias, *mlstm_f_bias, *mlstm_norm, *ln_g, *ln_b;
  float* out;
  unsigned char* ws;
  int ph_lo, ph_hi, coop, pad;
};

__device__ __forceinline__ int get_tid() { int t = threadIdx.x; asm volatile("" : "+v"(t)); return t; }
__device__ __forceinline__ u16 f2bf(float f) {
  f = fminf(fmaxf(f, -65000.f), 65000.f);
  _Float16 h = (_Float16)f;
  return __builtin_bit_cast(u16, h);
}
__device__ __forceinline__ float bf2f(u16 h) { return (float)__builtin_bit_cast(_Float16, h); }
__device__ __forceinline__ float siluf(float x) { return x / (1.f + __expf(-x)); }
__device__ __forceinline__ float sigmf(float x) { return 1.f / (1.f + __expf(-x)); }
__device__ __forceinline__ float softplusf(float x) { return x > 20.f ? x : log1pf(expf(x)); }
__device__ __forceinline__ float logsigf(float x) { return fminf(x, 0.f) - log1pf(expf(-fabsf(x))); }
__device__ __forceinline__ bf16x8 ldfrag72(const u16* base, int row, int ks, int fq) {
  return *(const bf16x8*)(base + row * 72 + ks * 32 + fq * 8);
}
using f16x8 = __attribute__((ext_vector_type(8))) _Float16;
__device__ __forceinline__ f32x4 mfma16(bf16x8 a, bf16x8 b, f32x4 c) {
  return __builtin_amdgcn_mfma_f32_16x16x32_f16(__builtin_bit_cast(f16x8, a), __builtin_bit_cast(f16x8, b), c, 0, 0, 0);
}
template <int CTRL> __device__ __forceinline__ float dpp_mov(float v) {
  return __builtin_bit_cast(float, __builtin_amdgcn_update_dpp(0, __builtin_bit_cast(int, v), CTRL, 0xF, 0xF, true));
}
__device__ __forceinline__ float red16_sum(float v) {
  v += dpp_mov<0xB1>(v); v += dpp_mov<0x4E>(v); v += dpp_mov<0x124>(v); v += dpp_mov<0x128>(v); return v;
}
__device__ __forceinline__ float red16_max(float v) {
  v = fmaxf(v, dpp_mov<0xB1>(v)); v = fmaxf(v, dpp_mov<0x4E>(v)); v = fmaxf(v, dpp_mov<0x124>(v)); v = fmaxf(v, dpp_mov<0x128>(v)); return v;
}
__device__ __forceinline__ float mod_get(const Params& p, int l, int b, int j) {
  return ((const float*)(p.ws + OFF_MOD))[(size_t)(l * 4 + b) * 9216 + j];
}
__device__ void mod_finalize(const Params& p) {
  const float* mp = (const float*)(p.ws + OFF_MODP);
  float* mo = (float*)(p.ws + OFF_MOD);
  for (int i = blockIdx.x * NT + get_tid(); i < 2 * 4 * 9216; i += gridDim.x * NT) {
    int j = i % 9216, lb = i / 9216, l = lb >> 2, b = lb & 3;
    float s = p.ada_b[l * 9216 + j];
    for (int ks = 0; ks < 8; ++ks) s += mp[(size_t)((l * 8 + ks) * 4 + b) * 9216 + j];
    mo[i] = s;
  }
}
__device__ __forceinline__ float ld_agent(const float* p) { return __hip_atomic_load(p, __ATOMIC_RELAXED, __HIP_MEMORY_SCOPE_AGENT); }
__device__ __forceinline__ int next_item(int* ctr) {
  __shared__ int s_item;
  __syncthreads();
  if (get_tid() == 0) s_item = atomicAdd(ctr, 1);
  __syncthreads();
  return s_item;
}

__device__ void modp_item(const Params& p, int item, unsigned char* smem) {
  int ks = item & 7, jc = (item >> 3) % 36, l = item / 288;
  float* sc = (float*)smem;
  int tid = get_tid();
  __syncthreads();
  for (int i = tid; i < 512; i += NT) { int b = i >> 7, k = i & 127; float cv = p.c[b * DM + ks * 128 + k]; sc[i] = cv / (1.f + expf(-cv)); }
  __syncthreads();
  int j = jc * 256 + tid;
  const float* w = p.ada_w + ((size_t)l * DM + ks * 128) * 9216 + j;
  float a0 = 0, a1 = 0, a2 = 0, a3 = 0;
#pragma unroll 8
  for (int k = 0; k < 128; ++k) { float wv = w[(size_t)k * 9216]; a0 += sc[k] * wv; a1 += sc[128 + k] * wv; a2 += sc[256 + k] * wv; a3 += sc[384 + k] * wv; }
  float* mp = (float*)(p.ws + OFF_MODP) + (size_t)((l * 8 + ks) * 4) * 9216 + j;
  mp[0] = a0; mp[9216] = a1; mp[2 * 9216] = a2; mp[3 * 9216] = a3;
}

__device__ __forceinline__ int win_map(int r) {
  if (r < 1152) return r;
  if (r < 2304) return 2316 + (r - 1152);
  if (r < 2560) return 1804 + (r - 2304);
  if (r < 2816) return 2060 + (r - 2560);
  if (r < 3200) return 1164 + (r - 2816);
  if (r < 3456) return 1548 + (r - 3200);
  if (r < 3840) return 3480 + (r - 3456);
  if (r < 3852) return 1152 + (r - 3840);
  if (r < 3864) return 3468 + (r - 3852);
  return -1;
}
#define NCONV_ITEMS 5472
__device__ void convert_item(const Params& p, int l, int idx, unsigned char* smem) {
  float* t = (float*)smem;
  int tid = get_tid();
  const float* src; u16* dst; int Nsrc, K, n0, k0, mode;
  u16* wt = (u16*)(p.ws + OFF_WT);
  if (idx < 2816) { int f = idx / 1408, r = idx % 1408; n0 = (r / 16) * 64; k0 = (r % 16) * 64; src = p.w13 + (size_t)(l * 2 + f) * 1024 * 5632; Nsrc = 5632; K = 1024; dst = wt + WT13_OFF(f); mode = 1; }
  else if (idx < 4224) { int q = idx - 2816; int f = q / 704, r = q % 704; n0 = (r / 44) * 64; k0 = (r % 44) * 64; src = p.w2 + (size_t)(l * 2 + f) * 2816 * 1024; Nsrc = 1024; K = 2816; dst = wt + WT2_OFF(f); mode = 0; }
  else if (idx < 5216) { int r = idx - 4224; n0 = (r / 16) * 64; k0 = (r % 16) * 64; src = p.w_in + (size_t)l * 1024 * 3864; Nsrc = 3864; K = 1024; dst = wt + WTIN_OFF; mode = 2; }
  else { int r = idx - 5216; n0 = (r / 16) * 64; k0 = (r % 16) * 64; src = p.w_out + (size_t)l * 1024 * 1024; Nsrc = 1024; K = 1024; dst = wt + WTOUT_OFF; mode = 0; }
  __syncthreads();
  {
    int c = tid & 63, kr = tid >> 6;
    int nd = n0 + c, ns;
    if (mode == 0) ns = nd;
    else if (mode == 1) { int grp = nd >> 6, w = nd & 63; ns = grp * 32 + (w & 31) + ((w & 32) ? 2816 : 0); }
    else ns = win_map(nd);
#pragma unroll 4
    for (int it = 0; it < 16; ++it) {
      int kk = it * 4 + kr;
      float v = (ns >= 0) ? src[(size_t)(k0 + kk) * Nsrc + ns] : 0.f;
      t[kk * 65 + c] = v;
    }
  }
  __syncthreads();
  {
    int n = tid >> 2, kq = tid & 3;
    unsigned pk[8];
#pragma unroll
    for (int i = 0; i < 8; ++i) {
      u16 lo = f2bf(t[(kq * 16 + 2 * i) * 65 + n]);
      u16 hi = f2bf(t[(kq * 16 + 2 * i + 1) * 65 + n]);
      pk[i] = (unsigned)lo | ((unsigned)hi << 16);
    }
    uint4* o = (uint4*)(dst + (size_t)(n0 + n) * K + k0 + kq * 16);
    o[0] = make_uint4(pk[0], pk[1], pk[2], pk[3]);
    o[1] = make_uint4(pk[4], pk[5], pk[6], pk[7]);
  }
}

__device__ void ln_phase(const Params& p, bool do_ln, int lg, int sg, bool do_a, int l2, int sub2) {
  int tid = get_tid(), lane = tid & 63;
  int gw = blockIdx.x * 4 + (tid >> 6), GW = gridDim.x * 4;
  int R = (NTOK + GW - 1) / GW;
  int r0 = gw * R, r1 = min(r0 + R, NTOK);
  const float* src = do_ln ? p.out : p.x;
  u16* A = (u16*)(p.ws + OFF_GDNI);
  float g[16], bb[16], sh[16], sc[16];
  if (do_ln) {
#pragma unroll
    for (int i = 0; i < 4; ++i)
#pragma unroll
      for (int e = 0; e < 4; ++e) { int col = i * 256 + lane * 4 + e; g[i * 4 + e] = p.ln_g[(lg * 3 + sg) * DM + col]; bb[i * 4 + e] = p.ln_b[(lg * 3 + sg) * DM + col]; }
  }
  int curb = -1;
  float xs[16];
#pragma unroll
  for (int i = 0; i < 16; ++i) xs[i] = 0.f;
  int xblk = -1;
  for (int r = r0; r < r1; ++r) {
    int b = r / SEQ;
    if (do_a && b != curb) {
      curb = b;
#pragma unroll
      for (int i = 0; i < 4; ++i)
#pragma unroll
        for (int e = 0; e < 4; ++e) { int col = i * 256 + lane * 4 + e; sh[i * 4 + e] = mod_get(p, l2, b, sub2 * 3072 + col); sc[i * 4 + e] = 1.f + mod_get(p, l2, b, sub2 * 3072 + 1024 + col); }
    }
    float v[16];
#pragma unroll
    for (int i = 0; i < 4; ++i) { float4 t = *(const float4*)(src + (size_t)r * DM + i * 256 + lane * 4); v[i * 4] = t.x; v[i * 4 + 1] = t.y; v[i * 4 + 2] = t.z; v[i * 4 + 3] = t.w; }
    if (do_ln) {
      float s = 0;
#pragma unroll
      for (int i = 0; i < 16; ++i) s += v[i];
#pragma unroll
      for (int o = 1; o < 64; o <<= 1) s += __shfl_xor(s, o);
      float mu = s * (1.f / 1024.f);
      float q = 0;
#pragma unroll
      for (int i = 0; i < 16; ++i) { float d = v[i] - mu; q += d * d; }
#pragma unroll
      for (int o = 1; o < 64; o <<= 1) q += __shfl_xor(q, o);
      float rs = rsqrtf(q * (1.f / 1024.f) + 1e-5f);
#pragma unroll
      for (int i = 0; i < 16; ++i) v[i] = (v[i] - mu) * rs * g[i] + bb[i];
#pragma unroll
      for (int i = 0; i < 4; ++i) *(float4*)(p.out + (size_t)r * DM + i * 256 + lane * 4) = make_float4(v[i * 4], v[i * 4 + 1], v[i * 4 + 2], v[i * 4 + 3]);
    }
    if (do_a && sub2 == 1) {
      u16* Alo = (u16*)(p.ws + OFF_ALO);
      int blk = r >> 8;
      if (blk != xblk) {
        if (xblk >= 0) {
          float* xb = (float*)(p.ws + OFF_XBAR) + (size_t)xblk * DM;
#pragma unroll
          for (int i = 0; i < 4; ++i)
#pragma unroll
            for (int e = 0; e < 4; ++e) { atomicAdd(xb + i * 256 + lane * 4 + e, xs[i * 4 + e]); xs[i * 4 + e] = 0.f; }
        }
        xblk = blk;
      }
#pragma unroll
      for (int i = 0; i < 4; ++i) {
        u16 lo[4];
#pragma unroll
        for (int e = 0; e < 4; ++e) {
          float xm = v[i * 4 + e] * sc[i * 4 + e] + sh[i * 4 + e];
          xs[i * 4 + e] += xm;
          lo[e] = f2bf(xm - bf2f(f2bf(xm)));
        }
        *(uint2*)(Alo + (size_t)r * DM + i * 256 + lane * 4) = make_uint2((unsigned)lo[0] | ((unsigned)lo[1] << 16), (unsigned)lo[2] | ((unsigned)lo[3] << 16));
      }
    }
    if (do_a) {
#pragma unroll
      for (int i = 0; i < 4; ++i) {
        u16 a0 = f2bf(v[i * 4] * sc[i * 4] + sh[i * 4]), a1 = f2bf(v[i * 4 + 1] * sc[i * 4 + 1] + sh[i * 4 + 1]);
        u16 a2 = f2bf(v[i * 4 + 2] * sc[i * 4 + 2] + sh[i * 4 + 2]), a3 = f2bf(v[i * 4 + 3] * sc[i * 4 + 3] + sh[i * 4 + 3]);
        *(uint2*)(A + (size_t)r * DM + i * 256 + lane * 4) = make_uint2((unsigned)a0 | ((unsigned)a1 << 16), (unsigned)a2 | ((unsigned)a3 << 16));
      }
    }
  }
  if (xblk >= 0) {
    float* xb = (float*)(p.ws + OFF_XBAR) + (size_t)xblk * DM;
#pragma unroll
    for (int i = 0; i < 4; ++i)
#pragma unroll
      for (int e = 0; e < 4; ++e) atomicAdd(xb + i * 256 + lane * 4 + e, xs[i * 4 + e]);
  }
}

__device__ void u_item(const Params& p, int l, int item, unsigned char* smem) {
  int h = item & 3, nb = (item >> 2) & 31, b = item >> 7, tid = get_tid();
  float* xb = (float*)smem; float* red = xb + 1024; float* kb = red + 256;
  const float* XB = (const float*)(p.ws + OFF_XBAR) + (size_t)(b * 32 + nb) * DM;
  const float* W = p.w_in + (size_t)l * 1024 * 3864;
  __syncthreads();
  for (int i = tid; i < 1024; i += NT) xb[i] = XB[i] * (1.f / 256.f);
  __syncthreads();
  {
    int j = tid & 63, kq = tid >> 6;
    const float* wk = W + (size_t)(kq * 256) * 3864 + 1804 + h * 64 + j;
    float s = 0.f;
#pragma unroll 8
    for (int k = 0; k < 256; ++k) s += xb[kq * 256 + k] * wk[(size_t)k * 3864];
    red[kq * 64 + j] = s;
  }
  __syncthreads();
  if (tid < 64) kb[tid] = red[tid] + red[64 + tid] + red[128 + tid] + red[192 + tid];
  __syncthreads();
  u16* UH = (u16*)(p.ws + OFF_UH) + ((size_t)b * 128 + h * 32 + nb) * 1024;
  u16* UL = (u16*)(p.ws + OFF_UL) + ((size_t)b * 128 + h * 32 + nb) * 1024;
  for (int i = 0; i < 4; ++i) {
    int k = i * 256 + tid;
    const float* wq = W + (size_t)k * 3864 + 1548 + h * 64;
    float s = 0.f;
#pragma unroll
    for (int j = 0; j < 64; j += 4) { float4 wv = *(const float4*)(wq + j); s += wv.x * kb[j] + wv.y * kb[j + 1] + wv.z * kb[j + 2] + wv.w * kb[j + 3]; }
    u16 hi = f2bf(s);
    UH[k] = hi; UL[k] = f2bf(s - bf2f(hi));
  }
}

enum { EPI_SWIGLU = 0, EPI_RES = 1, EPI_PROJ = 2 };
struct EpiArgs { const float* xres; int l, sub; float gs; };

__device__ __forceinline__ void gemm_stage(const u16* A, int lda, const u16* Bt, int K, int brow, int bcol, int kt, unsigned char* buf) {
  int tid = get_tid();
#pragma unroll
  for (int i = 0; i < 4; ++i) {
    int pidx = i * 256 + tid; int r = pidx >> 3, cp = pidx & 7; int cl = cp ^ ((r >> 1) & 7);
    __builtin_amdgcn_global_load_lds((const unsigned*)(A + (size_t)(brow + r) * lda + kt * 64 + cl * 8), (unsigned*)(buf + pidx * 16), 16, 0, 0);
  }
#pragma unroll
  for (int i = 0; i < 4; ++i) {
    int pidx = i * 256 + tid; int r = pidx >> 3, cp = pidx & 7; int cl = cp ^ ((r >> 1) & 7);
    __builtin_amdgcn_global_load_lds((const unsigned*)(Bt + (size_t)(bcol + r) * K + kt * 64 + cl * 8), (unsigned*)(buf + 16384 + pidx * 16), 16, 0, 0);
  }
}
__device__ __forceinline__ bf16x8 ldfrag_sw(const unsigned char* buf, int row, int cl) {
  return *(const bf16x8*)(buf + row * 128 + ((cl ^ ((row >> 1) & 7)) << 4));
}

template <int MODE>
__device__ void gemm_phase(const Params& p, const u16* A, int lda, const u16* Bt, int K, int ntn, EpiArgs ea, unsigned char* smem, int nt_fixed = -1, bool xcd_patch = false) {
  int tid = get_tid(), wid = tid >> 6, lane = tid & 63, wr = wid >> 1, wc = wid & 1, fr = lane & 15, fq = lane >> 4;
  int ntiles = (nt_fixed >= 0) ? 256 : 256 * ntn, nk = K / 64;
  int tstart = (nt_fixed >= 0) ? (int)((blockIdx.x + gridDim.x - (256 % gridDim.x)) % gridDim.x) : (int)blockIdx.x;
  bool patch = xcd_patch && nt_fixed < 0 && (gridDim.x & 7) == 0;
  int px = blockIdx.x & 7, pn0 = (ntn * (px & 3)) >> 2, png = ((ntn * ((px & 3) + 1)) >> 2) - pn0;
  int tstep = gridDim.x;
  if (patch) { tstart = blockIdx.x >> 3; ntiles = 128 * png; tstep = gridDim.x >> 3; }
  for (int t = tstart; t < ntiles; t += tstep) {
    int g = t / (8 * ntn), r = t % (8 * ntn);
    int mt = g * 8 + (r & 7), nt = r >> 3;
    if (nt_fixed >= 0) { mt = t; nt = nt_fixed; }
    if (patch) { mt = (px >> 2) * 128 + t / png; nt = pn0 + t % png; }
    int brow = mt * 128, bcol = nt * 128;
    f32x4 acc[4][4];
#pragma unroll
    for (int m = 0; m < 4; ++m)
#pragma unroll
      for (int n = 0; n < 4; ++n) acc[m][n] = (f32x4){0.f, 0.f, 0.f, 0.f};
    int b = brow / SEQ;
    const u16* B0 = Bt; const u16* B2 = Bt; const u16* A1 = A; int bc = bcol, npass = 1;
    if (MODE == EPI_PROJ && nt == 31) {
      B0 = (const u16*)(p.ws + OFF_UH) + (size_t)b * 128 * 1024; B2 = (const u16*)(p.ws + OFF_UL) + (size_t)b * 128 * 1024;
      A1 = (const u16*)(p.ws + OFF_ALO); bc = 0; npass = 3;
    }
    int nkt = nk * npass;
    __syncthreads();
    gemm_stage(A, lda, B0, K, brow, bc, 0, smem);
    for (int kt = 0; kt < nkt; ++kt) {
      asm volatile("s_waitcnt vmcnt(0)" ::: "memory");
      __syncthreads();
      unsigned char* cur = smem + (kt & 1) * 32768;
      if (kt + 1 < nkt) {
        int ps = (kt + 1) / nk, kk = (kt + 1) - ps * nk;
        gemm_stage(ps == 1 ? A1 : A, lda, ps == 2 ? B2 : B0, K, brow, bc, kk, smem + ((kt + 1) & 1) * 32768);
      }
#pragma unroll
      for (int ks = 0; ks < 2; ++ks) {
        bf16x8 af[4], bfr[4];
#pragma unroll
        for (int m = 0; m < 4; ++m) af[m] = ldfrag_sw(cur, wr * 64 + m * 16 + fr, ks * 4 + fq);
#pragma unroll
        for (int n = 0; n < 4; ++n) bfr[n] = ldfrag_sw(cur + 16384, wc * 64 + n * 16 + fr, ks * 4 + fq);
#pragma unroll
        for (int m = 0; m < 4; ++m)
#pragma unroll
          for (int n = 0; n < 4; ++n) acc[m][n] = mfma16(af[m], bfr[n], acc[m][n]);
      }
    }
    if (MODE == EPI_SWIGLU) {
      u16* hbuf = (u16*)(p.ws + OFF_PROJ);
#pragma unroll
      for (int m = 0; m < 4; ++m)
#pragma unroll
        for (int n = 0; n < 2; ++n) {
          int hid = (nt * 2 + wc) * 32 + n * 16 + fr;
#pragma unroll
          for (int j = 0; j < 4; ++j) {
            int row = brow + wr * 64 + m * 16 + fq * 4 + j;
            float a = acc[m][n][j], bv = acc[m][n + 2][j];
            hbuf[(size_t)row * DFF + hid] = f2bf(siluf(a) * bv);
          }
        }
    } else if (MODE == EPI_RES) {
#pragma unroll
      for (int n = 0; n < 4; ++n) {
        int col = bcol + wc * 64 + n * 16 + fr;
        float gate = ea.gs * (1.f + mod_get(p, ea.l, b, ea.sub * 3072 + 2048 + col));
#pragma unroll
        for (int m = 0; m < 4; ++m)
#pragma unroll
          for (int j = 0; j < 4; ++j) {
            int row = brow + wr * 64 + m * 16 + fq * 4 + j;
            size_t idx = (size_t)row * DM + col;
            p.out[idx] = ALPHA_F * ea.xres[idx] + gate * acc[m][n][j];
          }
      }
    } else {
      u16* proj = (u16*)(p.ws + OFF_PROJ);
      if (nt == 31) {
        float* gm = (float*)(p.ws + OFF_GM);
#pragma unroll
        for (int n = 0; n < 4; ++n) {
          int gc = wc * 64 + n * 16 + fr;
#pragma unroll
          for (int m = 0; m < 4; ++m)
#pragma unroll
            for (int j = 0; j < 4; ++j) { int row = brow + wr * 64 + m * 16 + fq * 4 + j; gm[(size_t)row * 128 + gc] = acc[m][n][j]; }
        }
      } else if (nt == 30) {
        float* gates = (float*)(p.ws + OFF_GATES);
#pragma unroll
        for (int n = 0; n < 4; ++n) {
          int gc = wc * 64 + n * 16 + fr;
          if (gc < 24) {
#pragma unroll
            for (int m = 0; m < 4; ++m)
#pragma unroll
              for (int j = 0; j < 4; ++j) { int row = brow + wr * 64 + m * 16 + fq * 4 + j; gates[(size_t)row * 24 + gc] = acc[m][n][j]; }
          }
        }
      } else if ((nt >= 15 && nt <= 17) || nt == 20 || nt == 21) {
        bool isc = nt < 18;
        u16* vt = (u16*)(p.ws + (isc ? OFF_VCT : OFF_VBT));
        int H = isc ? 6 : 4, cb = isc ? 1920 : 2560;
#pragma unroll
        for (int n = 0; n < 4; ++n) {
          int cc = bcol + wc * 64 + n * 16 + fr - cb; int head = cc >> 6, e = cc & 63;
#pragma unroll
          for (int m = 0; m < 4; ++m) {
            int tt = (brow - b * SEQ) + wr * 64 + m * 16 + fq * 4;
            u16 v0 = f2bf(acc[m][n][0]), v1 = f2bf(acc[m][n][1]), v2 = f2bf(acc[m][n][2]), v3 = f2bf(acc[m][n][3]);
            *(uint2*)(vt + ((size_t)(b * H + head) * 64 + e) * SEQ + tt) = make_uint2((unsigned)v0 | ((unsigned)v1 << 16), (unsigned)v2 | ((unsigned)v3 << 16));
          }
        }
      } else {
        int shift = nt < 15 ? 0 : (nt < 20 ? 384 : 640);
#pragma unroll
        for (int n = 0; n < 4; ++n) {
          int pc = bcol + wc * 64 + n * 16 + fr - shift;
#pragma unroll
          for (int m = 0; m < 4; ++m)
#pragma unroll
            for (int j = 0; j < 4; ++j) { int row = brow + wr * 64 + m * 16 + fq * 4 + j; proj[(size_t)row * PROJ_LD + pc] = f2bf(acc[m][n][j]); }
        }
      }
    }
  }
}

__device__ void mchain_item(const Params& p, int l, int bh, unsigned char* smem) {
  int b = bh / 6, h = bh % 6, tid = get_tid();
  float* bLs = (float*)smem; float* mws = bLs + 128;
  const float* gates = (const float*)(p.ws + OFF_GATES);
  __syncthreads();
  if (tid < 128) {
    float ib = p.mlstm_i_bias[l * 6 + h], fb = p.mlstm_f_bias[l * 6 + h];
    float bc = 0.f, mx = -INFINITY;
    size_t row = (size_t)b * SEQ + tid * 64;
    for (int s = 0; s < 64; ++s) {
      float ip = ld_agent(&gates[(row + s) * 24 + 12 + h]) + ib;
      float lf = logsigf(ld_agent(&gates[(row + s) * 24 + 18 + h]) + fb);
      bc += lf; mx = fmaxf(mx, ip - bc);
    }
    bLs[tid] = bc; mws[tid] = bc + mx;
  }
  __syncthreads();
  if (tid == 0) {
    float* mch = (float*)(p.ws + OFF_MCH) + bh * 129;
    float m = 0.f;
    for (int n = 0; n < 128; ++n) { mch[n] = m; m = fmaxf(bLs[n] + m, mws[n]); }
    mch[128] = m;
  }
}

__device__ void kmean_item(const Params& p, int item, unsigned char* smem) {
  int nb = item & 31, bh = item >> 5, b = bh >> 2, h = bh & 3, tid = get_tid();
  float* red = (float*)smem;
  const u16* proj = (const u16*)(p.ws + OFF_PROJ);
  int d = tid & 63, part = tid >> 6;
  float s = 0.f;
  for (int k = 0; k < 64; ++k) s += bf2f(proj[((size_t)b * SEQ + nb * 256 + part * 64 + k) * PROJ_LD + 1920 + h * 64 + d]);
  __syncthreads();
  red[tid] = s;
  __syncthreads();
  if (tid < 64) ((float*)(p.ws + OFF_KMEAN))[(size_t)item * 64 + tid] = (red[tid] + red[64 + tid] + red[128 + tid] + red[192 + tid]) * (1.f / 256.f);
}

__device__ __forceinline__ void conv_silu_tile(const u16* proj, int b, int t0, int pcol, const float* cw, int cwld, int ccol, float* dst, float post) {
  int tid = get_tid(), d = tid & 63, rg = tid >> 6;
  float w0 = cw[ccol + d], w1 = cw[cwld + ccol + d], w2 = cw[2 * cwld + ccol + d], w3 = cw[3 * cwld + ccol + d];
  int tl0 = t0 + rg * 16;
  const u16* base = proj + (size_t)b * SEQ * PROJ_LD + pcol + d;
  float xm3 = (tl0 - 3 >= 0) ? bf2f(base[(size_t)(tl0 - 3) * PROJ_LD]) : 0.f;
  float xm2 = (tl0 - 2 >= 0) ? bf2f(base[(size_t)(tl0 - 2) * PROJ_LD]) : 0.f;
  float xm1 = (tl0 - 1 >= 0) ? bf2f(base[(size_t)(tl0 - 1) * PROJ_LD]) : 0.f;
  float xr[16];
#pragma unroll
  for (int i = 0; i < 16; ++i) xr[i] = bf2f(base[(size_t)(tl0 + i) * PROJ_LD]);
#pragma unroll
  for (int i = 0; i < 16; ++i) {
    float x0 = xr[i];
    float y = w0 * xm3 + w1 * xm2 + w2 * xm1 + w3 * x0;
    dst[(rg * 16 + i) * 65 + d] = siluf(y) * post;
    xm3 = xm2; xm2 = xm1; xm1 = x0;
  }
}

__device__ void gdn_local_item(const Params& p, int l, int item, unsigned char* smem) {
  int n = item & 127, bh = item >> 7, b = bh / 6, h = bh % 6, tid = get_tid();
  float* qs = (float*)smem; float* ks = qs + 64 * 65; float* vs = ks + 64 * 65; float* As = vs + 64 * 65;
  float* Gs = As + 64 * 64; float* betas = Gs + 64; float* eGs = betas + 64;
  const u16* proj = (const u16*)(p.ws + OFF_PROJ);
  const float* gates = (const float*)(p.ws + OFF_GATES);
  u16* outb = (u16*)(p.ws + OFF_GDNI) + (size_t)item * GDNI_STRIDE;
  u16 *w_o = outb, *u_o = outb + 4096, *at_o = outb + 8192, *qd_o = outb + 12288, *kd_o = outb + 16384;
  int t0 = n * 64;
  __syncthreads();
  const float* cw = p.gdn_conv + (size_t)l * 4 * 1152;
  conv_silu_tile(proj, b, t0, h * 64, cw, 1152, h * 64, qs, 1.f);
  conv_silu_tile(proj, b, t0, 384 + h * 64, cw, 1152, 384 + h * 64, ks, 1.f);
  conv_silu_tile(proj, b, t0, 768 + h * 64, cw, 1152, 768 + h * 64, vs, 1.f);
  if (tid < 64) {
    size_t row = (size_t)b * SEQ + t0 + tid;
    float a = ld_agent(&gates[row * 24 + h]), br = ld_agent(&gates[row * 24 + 6 + h]);
    float g = -expf(p.gdn_a_log[l * 6 + h]) * softplusf(a + p.gdn_dt_bias[l * 6 + h]);
    float beta = 1.f / (1.f + expf(-br));
    float G = g;
#pragma unroll
    for (int o = 1; o < 64; o <<= 1) { float t = __shfl_up(G, o); if (tid >= o) G += t; }
    Gs[tid] = G; betas[tid] = beta; eGs[tid] = expf(G);
  }
  __syncthreads();
  {
    int row = tid >> 2, part = tid & 3;
    float sq = 0.f, sk = 0.f;
#pragma unroll
    for (int i = 0; i < 16; ++i) { float a = qs[row * 65 + part * 16 + i], c = ks[row * 65 + part * 16 + i]; sq += a * a; sk += c * c; }
    sq += dpp_mov<0xB1>(sq); sq += dpp_mov<0x4E>(sq); sk += dpp_mov<0xB1>(sk); sk += dpp_mov<0x4E>(sk);
    float rq = rsqrtf(sq + 1e-6f) * 0.125f, rk = rsqrtf(sk + 1e-6f);
#pragma unroll
    for (int i = 0; i < 16; ++i) { qs[row * 65 + part * 16 + i] *= rq; ks[row * 65 + part * 16 + i] *= rk; }
  }
  __syncthreads();
  {
    int ti = tid >> 4, tj = tid & 15;
    float kk[4][4], qk[4][4];
#pragma unroll
    for (int a = 0; a < 4; ++a)
#pragma unroll
      for (int c = 0; c < 4; ++c) { kk[a][c] = 0.f; qk[a][c] = 0.f; }
    if (tj <= ti) {
      for (int d = 0; d < 64; ++d) {
        float ki[4], qi[4], kj[4];
#pragma unroll
        for (int a = 0; a < 4; ++a) { ki[a] = ks[(ti * 4 + a) * 65 + d]; qi[a] = qs[(ti * 4 + a) * 65 + d]; kj[a] = ks[(tj * 4 + a) * 65 + d]; }
#pragma unroll
        for (int a = 0; a < 4; ++a)
#pragma unroll
          for (int c = 0; c < 4; ++c) { kk[a][c] += ki[a] * kj[c]; qk[a][c] += qi[a] * kj[c]; }
      }
    }
#pragma unroll
    for (int a = 0; a < 4; ++a) {
      int i = ti * 4 + a;
      u16 av[4];
#pragma unroll
      for (int c = 0; c < 4; ++c) {
        int j = tj * 4 + c;
        float dec = (j <= i) ? expf(Gs[i] - Gs[j]) : 0.f;
        As[i * 64 + j] = (j < i) ? betas[i] * kk[a][c] * dec : 0.f;
        av[c] = f2bf((j <= i) ? qk[a][c] * dec : 0.f);
      }
      *(uint2*)(at_o + i * 64 + tj * 4) = make_uint2((unsigned)av[0] | ((unsigned)av[1] << 16), (unsigned)av[2] | ((unsigned)av[3] << 16));
    }
  }
  __syncthreads();
  {
    int d = tid & 63, ig = tid >> 6;
    for (int ii = 0; ii < 16; ++ii) { int i = ig * 16 + ii; qd_o[i * 64 + d] = f2bf(qs[i * 65 + d] * eGs[i]); }
    int li = tid & 63;
    float kd = expf(Gs[63] - Gs[li]);
    for (int dd = 0; dd < 16; ++dd) { int dcol = ig * 16 + dd; kd_o[dcol * 64 + li] = f2bf(ks[li * 65 + dcol] * kd); }
    if (tid == 0) ((float*)(p.ws + OFF_GL))[item] = eGs[63];
  }
  __syncthreads();
  {
    int d = tid & 63, ig = tid >> 6;
    for (int ii = 0; ii < 16; ++ii) { int i = ig * 16 + ii; float bt = betas[i]; vs[i * 65 + d] *= bt; ks[i * 65 + d] *= bt * eGs[i]; }
  }
  __syncthreads();
  {
    int c = tid >> 1, half = tid & 1, cc = c & 63;
    float* buf = (c < 64) ? vs : ks;
    for (int i = 1; i < 64; ++i) {
      float s = 0.f;
      float s1 = 0.f; int j = half;
      for (; j + 2 < i; j += 4) { s += As[i * 64 + j] * buf[j * 65 + cc]; s1 += As[i * 64 + j + 2] * buf[(j + 2) * 65 + cc]; }
      for (; j < i; j += 2) s += As[i * 64 + j] * buf[j * 65 + cc];
      s += s1;
      s += dpp_mov<0xB1>(s);
      if (half == 0) buf[i * 65 + cc] -= s;
    }
  }
  __syncthreads();
  {
    int d = tid & 63, ig = tid >> 6;
    for (int ii = 0; ii < 16; ++ii) { int i = ig * 16 + ii; u_o[i * 64 + d] = f2bf(vs[i * 65 + d]); w_o[i * 64 + d] = f2bf(ks[i * 65 + d]); }
  }
}

__device__ void gdn_scan_item(const Params& p, int l, int bh, unsigned char* smem) {
  int b = bh / 6, h = bh % 6, tid = get_tid(), wid = tid >> 6, lane = tid & 63, fr = lane & 15, fq = lane >> 4;
  u16* Ws = (u16*)smem; u16* Us = Ws + 64 * 72; u16* ATs = Us + 64 * 72; u16* QDs = ATs + 64 * 72; u16* KDs = QDs + 64 * 72;
  u16* STs = KDs + 64 * 72; u16* VTs = STs + 64 * 72;
  u16* proj = (u16*)(p.ws + OFF_PROJ);
  const u16* gi = (const u16*)(p.ws + OFF_GDNI) + (size_t)bh * 128 * GDNI_STRIDE;
  const float* glast = (const float*)(p.ws + OFF_GL) + bh * 128;
  const float* gnorm = p.gdn_norm + l * 64;
  f32x4 st[4];
#pragma unroll
  for (int i = 0; i < 4; ++i) st[i] = (f32x4){0.f, 0.f, 0.f, 0.f};
  __syncthreads();
  for (int i = tid; i < 64 * 72; i += NT) STs[i] = 0;
  u32x4 pre[10], prb[10];
#pragma unroll
  for (int i = 0; i < 10; ++i) pre[i] = *(const u32x4*)(gi + (size_t)(i * 256 + tid) * 8);
#pragma unroll
  for (int i = 0; i < 10; ++i) { int q = i * 256 + tid; int mat = q >> 9, r = (q >> 3) & 63, c = q & 7; *(u32x4*)(Ws + mat * 64 * 72 + r * 72 + c * 8) = pre[i]; }
  __syncthreads();
  float gn[4];
#pragma unroll
  for (int nt = 0; nt < 4; ++nt) gn[nt] = gnorm[nt * 16 + fr];
  {
    const u16* g1 = gi + (size_t)GDNI_STRIDE;
#pragma unroll
    for (int i = 0; i < 10; ++i) pre[i] = *(const u32x4*)(g1 + (size_t)(i * 256 + tid) * 8);
  }
  auto step = [&](int n, u32x4 (&LD)[10], u32x4 (&WR)[10]) {
    if (n + 2 < 128) {
      const u16* g2 = gi + (size_t)(n + 2) * GDNI_STRIDE;
#pragma unroll
      for (int i = 0; i < 10; ++i) LD[i] = *(const u32x4*)(g2 + (size_t)(i * 256 + tid) * 8);
    }
    float gl = ld_agent(&glast[n]);
    float zr[4][4];
#pragma unroll
    for (int j = 0; j < 4; ++j) {
      size_t row = (size_t)b * SEQ + n * 64 + 16 * wid + fq * 4 + j;
#pragma unroll
      for (int nt = 0; nt < 4; ++nt) zr[j][nt] = bf2f(proj[row * PROJ_LD + 2176 + h * 64 + nt * 16 + fr]);
    }
    f32x4 c1[4];
#pragma unroll
    for (int i = 0; i < 4; ++i) c1[i] = (f32x4){0.f, 0.f, 0.f, 0.f};
#pragma unroll
    for (int ks = 0; ks < 2; ++ks) {
      bf16x8 a = ldfrag72(STs, 16 * wid + fr, ks, fq);
#pragma unroll
      for (int nt = 0; nt < 4; ++nt) c1[nt] = mfma16(a, ldfrag72(Ws, nt * 16 + fr, ks, fq), c1[nt]);
    }
#pragma unroll
    for (int nt = 0; nt < 4; ++nt) {
      int l_ = nt * 16 + fr;
      uint2 u4 = *(const uint2*)(Us + l_ * 72 + 16 * wid + fq * 4);
      u16 uu[4] = {(u16)(u4.x & 0xffffu), (u16)(u4.x >> 16), (u16)(u4.y & 0xffffu), (u16)(u4.y >> 16)};
#pragma unroll
      for (int j = 0; j < 4; ++j) { int e = 16 * wid + fq * 4 + j; VTs[e * 72 + l_] = f2bf(bf2f(uu[j]) - c1[nt][j]); }
    }
    __syncthreads();
    f32x4 o[4];
#pragma unroll
    for (int i = 0; i < 4; ++i) o[i] = (f32x4){0.f, 0.f, 0.f, 0.f};
#pragma unroll
    for (int ks = 0; ks < 2; ++ks) {
      bf16x8 a = ldfrag72(QDs, 16 * wid + fr, ks, fq);
#pragma unroll
      for (int nt = 0; nt < 4; ++nt) o[nt] = mfma16(a, ldfrag72(STs, nt * 16 + fr, ks, fq), o[nt]);
    }
#pragma unroll
    for (int ks = 0; ks < 2; ++ks) {
      bf16x8 a = ldfrag72(ATs, 16 * wid + fr, ks, fq);
#pragma unroll
      for (int nt = 0; nt < 4; ++nt) o[nt] = mfma16(a, ldfrag72(VTs, nt * 16 + fr, ks, fq), o[nt]);
    }
#pragma unroll
    for (int j = 0; j < 4; ++j) {
      float ss = o[0][j] * o[0][j] + o[1][j] * o[1][j] + o[2][j] * o[2][j] + o[3][j] * o[3][j];
      ss = red16_sum(ss);
      float rms = rsqrtf(ss * (1.f / 64.f) + 1e-6f);
      size_t row = (size_t)b * SEQ + n * 64 + 16 * wid + fq * 4 + j;
#pragma unroll
      for (int nt = 0; nt < 4; ++nt) {
        size_t idx = row * PROJ_LD + 2176 + h * 64 + nt * 16 + fr;
        float z = zr[j][nt];
        proj[idx] = f2bf(o[nt][j] * rms * gn[nt] * siluf(z));
      }
    }
#pragma unroll
    for (int nt = 0; nt < 4; ++nt) { st[nt][0] *= gl; st[nt][1] *= gl; st[nt][2] *= gl; st[nt][3] *= gl; }
#pragma unroll
    for (int ks = 0; ks < 2; ++ks) {
      bf16x8 a = ldfrag72(VTs, 16 * wid + fr, ks, fq);
#pragma unroll
      for (int nt = 0; nt < 4; ++nt) st[nt] = mfma16(a, ldfrag72(KDs, nt * 16 + fr, ks, fq), st[nt]);
    }
    __syncthreads();
#pragma unroll
    for (int nt = 0; nt < 4; ++nt)
#pragma unroll
      for (int j = 0; j < 4; ++j) STs[(16 * wid + fq * 4 + j) * 72 + nt * 16 + fr] = f2bf(st[nt][j]);
    if (n + 1 < 128) {
#pragma unroll
      for (int i = 0; i < 10; ++i) { int q = i * 256 + tid; int mat = q >> 9, r = (q >> 3) & 63, c = q & 7; *(u32x4*)(Ws + mat * 64 * 72 + r * 72 + c * 8) = WR[i]; }
    }
    __syncthreads();
  };
  for (int n = 0; n < 128; n += 2) { step(n, prb, pre); step(n + 1, pre, prb); }
}

__device__ void mlstm_local_item(const Params& p, int l, int item, unsigned char* smem) {
  int n = item & 127, bh = item >> 7, b = bh / 6, h = bh % 6, tid = get_tid();
  float* qs = (float*)smem; float* ks = qs + 64 * 65;
  float* bcs = ks + 64 * 65; float* ips = bcs + 64; float* mts = ips + 64; float* sws = mts + 64;
  const u16* proj = (const u16*)(p.ws + OFF_PROJ);
  const float* gates = (const float*)(p.ws + OFF_GATES);
  unsigned char* ob = p.ws + OFF_MLI + (size_t)item * MLI_STRIDE;
  u16 *qc_o = (u16*)ob, *P_o = qc_o + 4096, *sk_o = P_o + 4096;
  float* vec = (float*)(ob + 24576);
  const float* mch = (const float*)(p.ws + OFF_MCH) + bh * 129;
  int t0 = n * 64;
  __syncthreads();
  const float* cw = p.mlstm_conv + (size_t)l * 4 * 768;
  conv_silu_tile(proj, b, t0, 1152 + h * 64, cw, 768, h * 64, qs, 1.f);
  conv_silu_tile(proj, b, t0, 1536 + h * 64, cw, 768, 384 + h * 64, ks, 0.125f);
  if (tid < 64) {
    size_t row = (size_t)b * SEQ + t0 + tid;
    float ip = ld_agent(&gates[row * 24 + 12 + h]) + p.mlstm_i_bias[l * 6 + h];
    float lf = logsigf(ld_agent(&gates[row * 24 + 18 + h]) + p.mlstm_f_bias[l * 6 + h]);
    float bc = lf;
#pragma unroll
    for (int o = 1; o < 64; o <<= 1) { float t = __shfl_up(bc, o); if (tid >= o) bc += t; }
    float pm = ip - bc;
#pragma unroll
    for (int o = 1; o < 64; o <<= 1) { float t = __shfl_up(pm, o); if (tid >= o) pm = fmaxf(pm, t); }
    float m_in = ld_agent(&mch[n]), m_new = ld_agent(&mch[n + 1]);
    float inter = bc + m_in;
    float mt = fmaxf(inter, bc + pm);
    float bL = __shfl(bc, 63);
    float wend = bL - bc + ip;
    bcs[tid] = bc; ips[tid] = ip; mts[tid] = mt; sws[tid] = expf(wend - m_new);
    vec[tid] = expf(inter - mt);
    vec[64 + tid] = expf(-mt);
    if (tid == 0) vec[256] = expf(bL + m_in - m_new);
  }
  __syncthreads();
  {
    int ti = tid >> 4, tj = tid & 15;
    float qk[4][4];
#pragma unroll
    for (int a = 0; a < 4; ++a)
#pragma unroll
      for (int c = 0; c < 4; ++c) qk[a][c] = 0.f;
    if (tj <= ti) {
      for (int d = 0; d < 64; ++d) {
        float qi[4], kj[4];
#pragma unroll
        for (int a = 0; a < 4; ++a) { qi[a] = qs[(ti * 4 + a) * 65 + d]; kj[a] = ks[(tj * 4 + a) * 65 + d]; }
#pragma unroll
        for (int a = 0; a < 4; ++a)
#pragma unroll
          for (int c = 0; c < 4; ++c) qk[a][c] += qi[a] * kj[c];
      }
    }
#pragma unroll
    for (int a = 0; a < 4; ++a) {
      int i = ti * 4 + a;
      u16 pv[4]; float rs = 0.f;
#pragma unroll
      for (int c = 0; c < 4; ++c) {
        int j = tj * 4 + c;
        float pe = (j <= i) ? qk[a][c] * expf(bcs[i] - bcs[j] + ips[j] - mts[i]) : 0.f;
        rs += pe; pv[c] = f2bf(pe);
      }
      *(uint2*)(P_o + i * 64 + tj * 4) = make_uint2((unsigned)pv[0] | ((unsigned)pv[1] << 16), (unsigned)pv[2] | ((unsigned)pv[3] << 16));
      rs = red16_sum(rs);
      if (tj == 0) vec[128 + i] = rs;
    }
  }
  {
    int d = tid & 63, ig = tid >> 6;
    for (int ii = 0; ii < 16; ++ii) { int i = ig * 16 + ii; qc_o[i * 64 + d] = f2bf(qs[i * 65 + d]); }
    int li = tid & 63;
    float sw = sws[li];
    for (int dd = 0; dd < 16; ++dd) { int dcol = ig * 16 + dd; sk_o[dcol * 64 + li] = f2bf(sw * ks[li * 65 + dcol]); }
    if (tid < 64) {
      float s = 0.f;
      for (int i = 0; i < 64; ++i) s += sws[i] * ks[i * 65 + tid];
      vec[192 + tid] = s;
    }
  }
}

__device__ void mlstm_scan_item(const Params& p, int l, int bh, unsigned char* smem) {
  int b = bh / 6, h = bh % 6, tid = get_tid(), wid = tid >> 6, lane = tid & 63, fr = lane & 15, fq = lane >> 4;
  u16* QCs = (u16*)smem; u16* Ps = QCs + 64 * 72; u16* SKs = Ps + 64 * 72; u16* VTs = SKs + 64 * 72; u16* CTs = VTs + 64 * 72;
  float* nvec = (float*)(CTs + 64 * 72); float* qn = nvec + 64; float* vecs = qn + 64;
  u16* proj = (u16*)(p.ws + OFF_PROJ);
  const unsigned char* mi = p.ws + OFF_MLI + (size_t)bh * 128 * MLI_STRIDE;
  const u16* vct = (const u16*)(p.ws + OFF_VCT) + (size_t)bh * 64 * SEQ;
  const float* mnorm = p.mlstm_norm + l * 384 + h * 64;
  f32x4 ct[4];
#pragma unroll
  for (int i = 0; i < 4; ++i) ct[i] = (f32x4){0.f, 0.f, 0.f, 0.f};
  __syncthreads();
  for (int i = tid; i < 64 * 72; i += NT) CTs[i] = 0;
  if (tid < 64) nvec[tid] = 0.f;
  u32x4 pre[8], prb[8]; f32x4 prev = (f32x4){0.f, 0.f, 0.f, 0.f}, prvb = (f32x4){0.f, 0.f, 0.f, 0.f};
  {
    const u16* g2 = (const u16*)mi;
#pragma unroll
    for (int i = 0; i < 6; ++i) pre[i] = *(const u32x4*)(g2 + (size_t)(i * 256 + tid) * 8);
#pragma unroll
    for (int i = 0; i < 2; ++i) { int q = i * 256 + tid; int r = q >> 3, c = q & 7; pre[6 + i] = *(const u32x4*)(vct + (size_t)r * SEQ + c * 8); }
    if (tid < 80) prev = *(const f32x4*)(mi + 24576 + tid * 16);
#pragma unroll
    for (int i = 0; i < 6; ++i) { int q = i * 256 + tid; int mat = q >> 9, r = (q >> 3) & 63, c = q & 7; *(u32x4*)(QCs + mat * 64 * 72 + r * 72 + c * 8) = pre[i]; }
#pragma unroll
    for (int i = 0; i < 2; ++i) { int q = i * 256 + tid; int r = q >> 3, c = q & 7; *(u32x4*)(VTs + r * 72 + c * 8) = pre[6 + i]; }
    if (tid < 80) *(f32x4*)(vecs + tid * 4) = prev;
  }
  __syncthreads();
  float mn[4];
#pragma unroll
  for (int nt = 0; nt < 4; ++nt) mn[nt] = mnorm[nt * 16 + fr];
  {
    const unsigned char* m1 = mi + (size_t)MLI_STRIDE;
    const u16* g1 = (const u16*)m1;
#pragma unroll
    for (int i = 0; i < 6; ++i) pre[i] = *(const u32x4*)(g1 + (size_t)(i * 256 + tid) * 8);
#pragma unroll
    for (int i = 0; i < 2; ++i) { int q = i * 256 + tid; int r = q >> 3, c = q & 7; pre[6 + i] = *(const u32x4*)(vct + (size_t)r * SEQ + 64 + c * 8); }
    if (tid < 80) prev = *(const f32x4*)(m1 + 24576 + tid * 16);
  }
  auto step = [&](int n, u32x4 (&LD)[8], f32x4& LDV, u32x4 (&WR)[8], f32x4& WRV) {
    if (n + 2 < 128) {
      const unsigned char* m2 = mi + (size_t)(n + 2) * MLI_STRIDE;
      const u16* g2 = (const u16*)m2;
#pragma unroll
      for (int i = 0; i < 6; ++i) LD[i] = *(const u32x4*)(g2 + (size_t)(i * 256 + tid) * 8);
#pragma unroll
      for (int i = 0; i < 2; ++i) { int q = i * 256 + tid; int r = q >> 3, c = q & 7; LD[6 + i] = *(const u32x4*)(vct + (size_t)r * SEQ + (n + 2) * 64 + c * 8); }
      if (tid < 80) LDV = *(const f32x4*)(m2 + 24576 + tid * 16);
    }
    float orw[4][4];
#pragma unroll
    for (int j = 0; j < 4; ++j) {
      size_t row = (size_t)b * SEQ + n * 64 + 16 * wid + fq * 4 + j;
#pragma unroll
      for (int nt = 0; nt < 4; ++nt) orw[j][nt] = bf2f(proj[row * PROJ_LD + 2816 + h * 64 + nt * 16 + fr]);
    }
    {
      int l_ = tid >> 2, part = tid & 3;
      float s = 0.f;
#pragma unroll
      for (int i = 0; i < 16; ++i) s += bf2f(QCs[l_ * 72 + part * 16 + i]) * nvec[part * 16 + i];
      s += dpp_mov<0xB1>(s); s += dpp_mov<0x4E>(s);
      if (part == 0) qn[l_] = s;
    }
    __syncthreads();
    float decay = vecs[256];
    f32x4 a1[4], a2[4];
#pragma unroll
    for (int i = 0; i < 4; ++i) { a1[i] = (f32x4){0.f, 0.f, 0.f, 0.f}; a2[i] = (f32x4){0.f, 0.f, 0.f, 0.f}; }
#pragma unroll
    for (int ks = 0; ks < 2; ++ks) {
      bf16x8 a = ldfrag72(QCs, 16 * wid + fr, ks, fq);
#pragma unroll
      for (int nt = 0; nt < 4; ++nt) a1[nt] = mfma16(a, ldfrag72(CTs, nt * 16 + fr, ks, fq), a1[nt]);
    }
#pragma unroll
    for (int ks = 0; ks < 2; ++ks) {
      bf16x8 a = ldfrag72(Ps, 16 * wid + fr, ks, fq);
#pragma unroll
      for (int nt = 0; nt < 4; ++nt) a2[nt] = mfma16(a, ldfrag72(VTs, nt * 16 + fr, ks, fq), a2[nt]);
    }
#pragma unroll
    for (int j = 0; j < 4; ++j) {
      int l_ = 16 * wid + fq * 4 + j;
      float ai = vecs[l_], en = vecs[64 + l_], rs = vecs[128 + l_];
      float den = ai * qn[l_] + rs;
      float dn = fmaxf(fabsf(den), en);
      float inv = 1.f / dn;
      size_t row = (size_t)b * SEQ + n * 64 + l_;
      float hv[4]; float s = 0.f;
#pragma unroll
      for (int nt = 0; nt < 4; ++nt) {
        size_t idx = row * PROJ_LD + 2816 + h * 64 + nt * 16 + fr;
        float og = sigmf(orw[j][nt]);
        hv[nt] = (ai * a1[nt][j] + a2[nt][j]) * inv * og;
        s += hv[nt];
      }
      s = red16_sum(s);
      float mu = s * (1.f / 64.f);
      float q = 0.f;
#pragma unroll
      for (int nt = 0; nt < 4; ++nt) { float d = hv[nt] - mu; q += d * d; }
      q = red16_sum(q);
      float rstd = rsqrtf(q * (1.f / 64.f) + 1e-6f);
#pragma unroll
      for (int nt = 0; nt < 4; ++nt) {
        size_t idx = row * PROJ_LD + 2816 + h * 64 + nt * 16 + fr;
        proj[idx] = f2bf((hv[nt] - mu) * rstd * mn[nt]);
      }
    }
#pragma unroll
    for (int nt = 0; nt < 4; ++nt) { ct[nt][0] *= decay; ct[nt][1] *= decay; ct[nt][2] *= decay; ct[nt][3] *= decay; }
#pragma unroll
    for (int ks = 0; ks < 2; ++ks) {
      bf16x8 a = ldfrag72(VTs, 16 * wid + fr, ks, fq);
#pragma unroll
      for (int nt = 0; nt < 4; ++nt) ct[nt] = mfma16(a, ldfrag72(SKs, nt * 16 + fr, ks, fq), ct[nt]);
    }
    float nnew = 0.f;
    if (tid < 64) nnew = decay * nvec[tid] + vecs[192 + tid];
    __syncthreads();
#pragma unroll
    for (int nt = 0; nt < 4; ++nt)
#pragma unroll
      for (int j = 0; j < 4; ++j) CTs[(16 * wid + fq * 4 + j) * 72 + nt * 16 + fr] = f2bf(ct[nt][j]);
    if (tid < 64) nvec[tid] = nnew;
    if (n + 1 < 128) {
#pragma unroll
      for (int i = 0; i < 6; ++i) { int q = i * 256 + tid; int mat = q >> 9, r = (q >> 3) & 63, c = q & 7; *(u32x4*)(QCs + mat * 64 * 72 + r * 72 + c * 8) = WR[i]; }
#pragma unroll
      for (int i = 0; i < 2; ++i) { int q = i * 256 + tid; int r = q >> 3, c = q & 7; *(u32x4*)(VTs + r * 72 + c * 8) = WR[6 + i]; }
      if (tid < 80) *(f32x4*)(vecs + tid * 4) = WRV;
    }
    __syncthreads();
  };
  for (int n = 0; n < 128; n += 2) { step(n, prb, prvb, pre, prev); step(n + 1, pre, prev, prb, prvb); }
}

__device__ __forceinline__ bool moba_next(int& blk, int& kt, int own, int nown, unsigned um) {
  ++kt;
  for (;;) {
    if (blk > own) return false;
    bool isown = (blk == own);
    bool sel = isown || ((um >> blk) & 1u);
    int ntile = isown ? nown : 4;
    if (sel && kt < ntile) return true;
    ++blk; kt = 0;
  }
}
__device__ void moba_item(const Params& p, int idx, unsigned char* smem) {
  int qt = 127 - (idx >> 4), bh = idx & 15, b = bh >> 2, h = bh & 3;
  int tid = get_tid(), wid = tid >> 6, lane = tid & 63, fr = lane & 15, fq = lane >> 4;
  int t0 = qt * 64, own = t0 >> 8;
  u16* KV = (u16*)smem;
  u16* Qs = KV + 4 * 64 * 72; u16* Ps = Qs + 64 * 72;
  float* km = (float*)(Ps + 64 * 72);
  float* gate = km + 32 * 64;
  unsigned* selm = (unsigned*)(gate + 64 * 33);
  unsigned* uni = selm + 64;
  u16* proj = (u16*)(p.ws + OFF_PROJ);
  const u16* vbt = (const u16*)(p.ws + OFF_VBT) + (size_t)bh * 64 * SEQ;
  const u16* kbase = proj + (size_t)b * SEQ * PROJ_LD + 1920 + h * 64;
  const float* kmean = (const float*)(p.ws + OFF_KMEAN) + (size_t)bh * 32 * 64;
  __syncthreads();
#pragma unroll
  for (int i = 0; i < 2; ++i) { int q = i * 256 + tid; int r = q >> 3, c = q & 7; *(u32x4*)(Qs + r * 72 + c * 8) = *(const u32x4*)(proj + ((size_t)b * SEQ + t0 + r) * PROJ_LD + 2560 + h * 64 + c * 8); }
  if (tid == 0) *uni = 0u;
  {
    const float* gm = (const float*)(p.ws + OFF_GM) + ((size_t)b * SEQ + t0) * 128 + h * 32;
    for (int i = tid; i < 64 * 32; i += NT) { int q = i >> 5, nb = i & 31; if (nb < own) gate[q * 33 + nb] = gm[(size_t)q * 128 + nb]; }
  }
  __syncthreads();
  if (tid < 64) {
    unsigned m = 0u;
    for (int r = 0; r < 3; ++r) {
      float best = -INFINITY; int bi = -1;
      for (int nb = 0; nb < own; ++nb) { float gv = gate[tid * 33 + nb]; if (!((m >> nb) & 1u) && gv > best) { best = gv; bi = nb; } }
      if (bi >= 0) m |= (1u << bi);
    }
    selm[tid] = m;
    if (m) atomicOr(uni, m);
  }
  __syncthreads();
  unsigned um = *uni;
  bf16x8 qf[2];
  qf[0] = ldfrag72(Qs, 16 * wid + fr, 0, fq); qf[1] = ldfrag72(Qs, 16 * wid + fr, 1, fq);
  unsigned mysel[4]; float mrun[4], lrun[4];
#pragma unroll
  for (int j = 0; j < 4; ++j) { mysel[j] = selm[16 * wid + fq * 4 + j]; mrun[j] = -INFINITY; lrun[j] = 0.f; }
  f32x4 o[4];
#pragma unroll
  for (int i = 0; i < 4; ++i) o[i] = (f32x4){0.f, 0.f, 0.f, 0.f};
  int nown = ((t0 - own * 256) >> 6) + 1;
  int blk = 0, kt = -1;
  bool have = moba_next(blk, kt, own, nown, um);
  u32x4 pk[2], pv[2];
  {
    int key0 = blk * 256 + kt * 64;
#pragma unroll
    for (int i = 0; i < 2; ++i) {
      int q = i * 256 + tid; int r = q >> 3, c = q & 7;
      pk[i] = *(const u32x4*)(kbase + (size_t)(key0 + r) * PROJ_LD + c * 8);
      pv[i] = *(const u32x4*)(vbt + (size_t)r * SEQ + key0 + c * 8);
    }
#pragma unroll
    for (int i = 0; i < 2; ++i) {
      int q = i * 256 + tid; int r = q >> 3, c = q & 7;
      *(u32x4*)(KV + r * 72 + c * 8) = pk[i];
      *(u32x4*)(KV + 64 * 72 + r * 72 + c * 8) = pv[i];
    }
  }
  __syncthreads();
  int it = 0;
  while (have) {
    int cblk = blk, ckt = kt;
    bool hn = moba_next(blk, kt, own, nown, um);
    if (hn) {
      int key0n = blk * 256 + kt * 64;
#pragma unroll
      for (int i = 0; i < 2; ++i) {
        int q = i * 256 + tid; int r = q >> 3, c = q & 7;
        pk[i] = *(const u32x4*)(kbase + (size_t)(key0n + r) * PROJ_LD + c * 8);
        pv[i] = *(const u32x4*)(vbt + (size_t)r * SEQ + key0n + c * 8);
      }
    }
    const u16* Ks = KV + (it & 1) * 2 * 64 * 72; const u16* Vts = Ks + 64 * 72;
    bool isown = (cblk == own);
    int key0 = cblk * 256 + ckt * 64;
    f32x4 s[4];
#pragma unroll
    for (int i = 0; i < 4; ++i) s[i] = (f32x4){0.f, 0.f, 0.f, 0.f};
#pragma unroll
    for (int ks = 0; ks < 2; ++ks)
#pragma unroll
      for (int nt = 0; nt < 4; ++nt) s[nt] = mfma16(qf[ks], ldfrag72(Ks, nt * 16 + fr, ks, fq), s[nt]);
#pragma unroll
    for (int j = 0; j < 4; ++j) {
      int qpos = t0 + 16 * wid + fq * 4 + j;
      bool rowok = isown ? true : (((mysel[j] >> cblk) & 1u) != 0u);
      float mx = -INFINITY;
#pragma unroll
      for (int nt = 0; nt < 4; ++nt) {
        int key = key0 + nt * 16 + fr;
        bool ok = isown ? (key <= qpos) : rowok;
        float v = ok ? s[nt][j] * 0.125f : -INFINITY;
        s[nt][j] = v; mx = fmaxf(mx, v);
      }
      mx = red16_max(mx);
      float mnew = fmaxf(mrun[j], mx);
      float msafe = (mnew == -INFINITY) ? 0.f : mnew;
      float sc = __expf(mrun[j] - msafe);
      float ps = 0.f;
#pragma unroll
      for (int nt = 0; nt < 4; ++nt) { float pe = __expf(s[nt][j] - msafe); ps += pe; s[nt][j] = pe; }
      ps = red16_sum(ps);
      lrun[j] = lrun[j] * sc + ps; mrun[j] = mnew;
#pragma unroll
      for (int nt = 0; nt < 4; ++nt) o[nt][j] *= sc;
    }
#pragma unroll
    for (int nt = 0; nt < 4; ++nt)
#pragma unroll
      for (int j = 0; j < 4; ++j) Ps[(16 * wid + fq * 4 + j) * 72 + nt * 16 + fr] = f2bf(s[nt][j]);
    asm volatile("s_waitcnt lgkmcnt(0)" ::: "memory");
#pragma unroll
    for (int ks = 0; ks < 2; ++ks) {
      bf16x8 a = ldfrag72(Ps, 16 * wid + fr, ks, fq);
#pragma unroll
      for (int nt = 0; nt < 4; ++nt) o[nt] = mfma16(a, ldfrag72(Vts, nt * 16 + fr, ks, fq), o[nt]);
    }
    if (hn) {
      u16* Kn = KV + ((it + 1) & 1) * 2 * 64 * 72;
#pragma unroll
      for (int i = 0; i < 2; ++i) {
        int q = i * 256 + tid; int r = q >> 3, c = q & 7;
        *(u32x4*)(Kn + r * 72 + c * 8) = pk[i];
        *(u32x4*)(Kn + 64 * 72 + r * 72 + c * 8) = pv[i];
      }
    }
    __syncthreads();
    have = hn; ++it;
  }
#pragma unroll
  for (int j = 0; j < 4; ++j) {
    float inv = 1.f / lrun[j];
    size_t row = (size_t)b * SEQ + t0 + 16 * wid + fq * 4 + j;
#pragma unroll
    for (int nt = 0; nt < 4; ++nt) proj[row * PROJ_LD + 2560 + h * 64 + nt * 16 + fr] = f2bf(o[nt][j] * inv);
  }
}

__device__ __forceinline__ void grid_barrier(unsigned* bar, unsigned target) {
  asm volatile("s_waitcnt vmcnt(0) lgkmcnt(0)" ::: "memory");
  __syncthreads();
  if (threadIdx.x == 0) {
    __builtin_amdgcn_fence(__ATOMIC_RELEASE, "agent");
    asm volatile("s_waitcnt vmcnt(0)" ::: "memory");
    __hip_atomic_fetch_add(bar, 1u, __ATOMIC_RELAXED, __HIP_MEMORY_SCOPE_AGENT);
    while (__hip_atomic_load(bar, __ATOMIC_RELAXED, __HIP_MEMORY_SCOPE_AGENT) < target) __builtin_amdgcn_s_sleep(2);
    __builtin_amdgcn_fence(__ATOMIC_ACQUIRE, "agent");
    asm volatile("s_waitcnt vmcnt(0)" ::: "memory");
  }
  __syncthreads();
  asm volatile("buffer_inv sc1\n\ts_waitcnt vmcnt(0)" ::: "memory");
}

__global__ void __launch_bounds__(NT, 2) fwd_megakernel(Params p) {
  __shared__ __attribute__((aligned(16))) unsigned char smem[SMEM_BYTES];
  cg::grid_group grid = cg::this_grid();
  int* ctr = (int*)(p.ws + OFF_CTR);
  u16* wt = (u16*)(p.ws + OFF_WT);
  u16* Abuf = (u16*)(p.ws + OFF_GDNI);
  u16* hbuf = (u16*)(p.ws + OFF_PROJ);
  int ph = 0;
#define PH_BEGIN if (ph >= p.ph_lo && ph < p.ph_hi) {
#define PH_END } ++ph; if (p.coop && ph > p.ph_lo && ph < p.ph_hi) { grid_barrier(gbar, (unsigned)(ph - p.ph_lo) * gridDim.x); }
  unsigned* gbar = (unsigned*)(p.ws + OFF_CTR) + 1024;
  if (p.coop) grid.sync();
  PH_BEGIN
    for (int it = blockIdx.x; it < 576 + NCONV_ITEMS; it += gridDim.x) {
      if (it < 576) modp_item(p, it, smem); else convert_item(p, 0, it - 576, smem);
    }
  PH_END
  PH_BEGIN
    mod_finalize(p);
  PH_END
  PH_BEGIN
    ln_phase(p, false, 0, 0, true, 0, 0);
  PH_END
  for (int l0 = 0; l0 < 2; ++l0) {
    int l = l0; asm volatile("" : "+s"(l));
    EpiArgs ea;
    PH_BEGIN
      ea.xres = nullptr; ea.l = l; ea.sub = 0; ea.gs = 0.f;
      gemm_phase<EPI_SWIGLU>(p, Abuf, DM, wt + WT13_OFF(0), 1024, 44, ea, smem, -1, true);
    PH_END
    PH_BEGIN
      ea.xres = (l == 0) ? p.x : p.out; ea.l = l; ea.sub = 0; ea.gs = 0.5f;
      gemm_phase<EPI_RES>(p, hbuf, DFF, wt + WT2_OFF(0), 2816, 8, ea, smem);
    PH_END
    PH_BEGIN
      ln_phase(p, true, l, 0, true, l, 1);
    PH_END
    PH_BEGIN
      for (int it = blockIdx.x; it < 512; it += gridDim.x) u_item(p, l, it, smem);
    PH_END
    PH_BEGIN
      ea.xres = nullptr; ea.l = l; ea.sub = 1; ea.gs = 0.f;
      gemm_phase<EPI_PROJ>(p, Abuf, DM, wt + WTIN_OFF, 1024, 31, ea, smem, -1, true);
      gemm_phase<EPI_PROJ>(p, Abuf, DM, wt + WTIN_OFF, 1024, 31, ea, smem, 31);
      { float* xbz = (float*)(p.ws + OFF_XBAR);
        for (int i = blockIdx.x * NT + get_tid(); i < 128 * 1024; i += gridDim.x * NT) xbz[i] = 0.f; }
    PH_END
    PH_BEGIN
      int* c = ctr + (l * 3 + 0) * 16;
      for (;;) {
        int it = next_item(c);
        if (it >= 24 + 3072) break;
        if (it < 24) mchain_item(p, l, it, smem);
        else gdn_local_item(p, l, it - 24, smem);
      }
    PH_END
    PH_BEGIN
      int* c = ctr + (l * 3 + 1) * 16;
      if (blockIdx.x < 24) { __builtin_amdgcn_s_setprio(3); gdn_scan_item(p, l, blockIdx.x, smem); __builtin_amdgcn_s_setprio(0); }
      if (!(gridDim.x == 512 && blockIdx.x >= 256 && blockIdx.x < 280))
      for (;;) {
        int it = next_item(c) + 24;
        if (it >= 24 + 3072 + 1024) break;
        if (it < 3096) mlstm_local_item(p, l, it - 24, smem);
        else moba_item(p, it - 3096, smem);
      }
    PH_END
    PH_BEGIN
      int* c = ctr + (l * 3 + 2) * 16;
      if (blockIdx.x < 24) { __builtin_amdgcn_s_setprio(3); mlstm_scan_item(p, l, blockIdx.x, smem); __builtin_amdgcn_s_setprio(0); }
      if (!(gridDim.x == 512 && blockIdx.x >= 256 && blockIdx.x < 280))
      for (;;) {
        int it = next_item(c) + 24;
        if (it >= 24 + 1024) break;
        moba_item(p, 1024 + it - 24, smem);
      }
    PH_END
    PH_BEGIN
      ea.xres = p.out; ea.l = l; ea.sub = 1; ea.gs = 1.0f;
      gemm_phase<EPI_RES>(p, hbuf + 2176, PROJ_LD, wt + WTOUT_OFF, 1024, 8, ea, smem);
    PH_END
    PH_BEGIN
      ln_phase(p, true, l, 1, true, l, 2);
    PH_END
    PH_BEGIN
      ea.xres = nullptr; ea.l = l; ea.sub = 2; ea.gs = 0.f;
      gemm_phase<EPI_SWIGLU>(p, Abuf, DM, wt + WT13_OFF(1), 1024, 44, ea, smem, -1, true);
    PH_END
    PH_BEGIN
      ea.xres = p.out; ea.l = l; ea.sub = 2; ea.gs = 0.5f;
      gemm_phase<EPI_RES>(p, hbuf, DFF, wt + WT2_OFF(1), 2816, 8, ea, smem);
    PH_END
    PH_BEGIN
      ln_phase(p, true, l, 2, l == 0, 1, 0);
      if (l == 0) for (int it = blockIdx.x; it < NCONV_ITEMS; it += gridDim.x) convert_item(p, 1, it, smem);
    PH_END
  }
}

#define N_PHASES 29

extern "C" void kernel_launch(void* const* d_in, const int* in_sizes, int n_in, void* d_out, int out_size,
                              void* d_ws, size_t ws_size, hipStream_t stream) {
  static int grid_blocks = 0;
  if (!grid_blocks) {
    int dev = 0, cus = 0, per_cu = 0;
    hipGetDevice(&dev);
    hipDeviceGetAttribute(&cus, hipDeviceAttributeMultiprocessorCount, dev);
    hipOccupancyMaxActiveBlocksPerMultiprocessor(&per_cu, fwd_megakernel, NT, 0);
    if (per_cu > 2) per_cu = 2;
    if (per_cu < 1) per_cu = 1;
    grid_blocks = cus * per_cu;
  }
  if (ws_size < WS_NEEDED) { fprintf(stderr, "workspace too small: %zu\n", ws_size); return; }
  Params p{};
  const float** f = (const float**)d_in;
  p.x = f[0]; p.c = f[1]; p.ada_w = f[2]; p.ada_b = f[3]; p.w13 = f[4]; p.w2 = f[5]; p.w_in = f[6]; p.w_out = f[7];
  p.gdn_conv = f[8]; p.gdn_a_log = f[9]; p.gdn_dt_bias = f[10]; p.gdn_norm = f[11]; p.mlstm_conv = f[12];
  p.mlstm_i_bias = f[13]; p.mlstm_f_bias = f[14]; p.mlstm_norm = f[15]; p.ln_g = f[16]; p.ln_b = f[17];
  p.out = (float*)d_out; p.ws = (unsigned char*)d_ws;
  p.ph_lo = 0; p.ph_hi = N_PHASES; p.coop = 1; p.pad = 0;
  hipMemsetAsync((unsigned char*)d_ws + OFF_CTR, 0, 128 * 1024 + 512 * 1024, stream);
  void* args[] = {&p};
  hipError_t e = hipLaunchCooperativeKernel((void*)fwd_megakernel, dim3(grid_blocks), dim3(NT), args, 0, stream);
  if (e != hipSuccess) fprintf(stderr, "cooperative launch failed: %s (grid %d)\n", hipGetErrorString(e), grid_blocks);
}
```

```cpp
#include <hip/hip_runtime.h>
#include <hip/hip_cooperative_groups.h>
#include <cstdio>
namespace cg = cooperative_groups;

typedef unsigned short u16;
using bf16x8 = __attribute__((ext_vector_type(8))) short;
using f32x4  = __attribute__((ext_vector_type(4))) float;
using u32x4  = __attribute__((ext_vector_type(4))) unsigned;

#define NTOK 32768
#define SEQ 8192
#define DM 1024
#define DFF 2816
#define PROJ_LD 3200
#define NT 256
#define SMEM_BYTES 73728
#define ALPHA_F 1.4142135623730951f

#define MiB (1024ull*1024ull)
#define OFF_PROJ   (0ull)
#define OFF_GDNI   (200ull*MiB)
#define OFF_MLI    (320ull*MiB)
#define OFF_WT     (396ull*MiB)
#define OFF_VCT    (439ull*MiB)
#define OFF_VBT    (463ull*MiB)
#define OFF_GATES  (479ull*MiB)
#define OFF_MODP   (482ull*MiB)
#define OFF_MOD    (484ull*MiB + 512*1024)
#define OFF_KMEAN  (485ull*MiB)
#define OFF_MCH    (485ull*MiB + 256*1024)
#define OFF_GL     (485ull*MiB + 320*1024)
#define OFF_CTR    (485ull*MiB + 384*1024)
#define OFF_XBAR   (485ull*MiB + 512*1024)
#define OFF_UH     (486ull*MiB)
#define OFF_UL     (487ull*MiB)
#define OFF_GM     (488ull*MiB)
#define OFF_ALO    OFF_MLI
#define WS_NEEDED  (504ull*MiB)

#define GDNI_STRIDE 20480
#define MLI_STRIDE  25856

#define WT13_OFF(f) ((size_t)(f)*5632*1024)
#define WT2_OFF(f)  ((size_t)2*5632*1024 + (size_t)(f)*1024*2816)
#define WTIN_OFF    ((size_t)2*5632*1024 + (size_t)2*1024*2816)
#define WTOUT_OFF   (WTIN_OFF + (size_t)3968*1024)

struct Params {
  const float *x, *c, *ada_w, *ada_b, *w13, *w2, *w_in, *w_out, *gdn_conv, *gdn_a_log, *gdn_dt_bias, *gdn_norm,
              *mlstm_conv, *mlstm_i_bias, *mlstm_f_bias, *mlstm_norm, *ln_g, *ln_b;
  float* out;
  unsigned char* ws;
  int ph_lo, ph_hi, coop, pad;
};

__device__ __forceinline__ int get_tid() { int t = threadIdx.x; asm volatile("" : "+v"(t)); return t; }
__device__ __forceinline__ u16 f2bf(float f) {
  f = fminf(fmaxf(f, -65000.f), 65000.f);
  _Float16 h = (_Float16)f;
  return __builtin_bit_cast(u16, h);
}
__device__ __forceinline__ float bf2f(u16 h) { return (float)__builtin_bit_cast(_Float16, h); }
__device__ __forceinline__ float siluf(float x) { return x / (1.f + __expf(-x)); }
__device__ __forceinline__ float sigmf(float x) { return 1.f / (1.f + __expf(-x)); }
__device__ __forceinline__ float softplusf(float x) { return x > 20.f ? x : log1pf(expf(x)); }
__device__ __forceinline__ float logsigf(float x) { return fminf(x, 0.f) - log1pf(expf(-fabsf(x))); }
__device__ __forceinline__ bf16x8 ldfrag72(const u16* base, int row, int ks, int fq) {
  return *(const bf16x8*)(base + row * 72 + ks * 32 + fq * 8);
}
using f16x8 = __attribute__((ext_vector_type(8))) _Float16;
__device__ __forceinline__ f32x4 mfma16(bf16x8 a, bf16x8 b, f32x4 c) {
  return __builtin_amdgcn_mfma_f32_16x16x32_f16(__builtin_bit_cast(f16x8, a), __builtin_bit_cast(f16x8, b), c, 0, 0, 0);
}
template <int CTRL> __device__ __forceinline__ float dpp_mov(float v) {
  return __builtin_bit_cast(float, __builtin_amdgcn_update_dpp(0, __builtin_bit_cast(int, v), CTRL, 0xF, 0xF, true));
}
__device__ __forceinline__ float red16_sum(float v) {
  v += dpp_mov<0xB1>(v); v += dpp_mov<0x4E>(v); v += dpp_mov<0x124>(v); v += dpp_mov<0x128>(v); return v;
}
__device__ __forceinline__ float red16_max(float v) {
  v = fmaxf(v, dpp_mov<0xB1>(v)); v = fmaxf(v, dpp_mov<0x4E>(v)); v = fmaxf(v, dpp_mov<0x124>(v)); v = fmaxf(v, dpp_mov<0x128>(v)); return v;
}
__device__ __forceinline__ float mod_get(const Params& p, int l, int b, int j) {
  return ((const float*)(p.ws + OFF_MOD))[(size_t)(l * 4 + b) * 9216 + j];
}
__device__ void mod_finalize(const Params& p) {
  const float* mp = (const float*)(p.ws + OFF_MODP);
  float* mo = (float*)(p.ws + OFF_MOD);
  for (int i = blockIdx.x * NT + get_tid(); i < 2 * 4 * 9216; i += gridDim.x * NT) {
    int j = i % 9216, lb = i / 9216, l = lb >> 2, b = lb & 3;
    float s = p.ada_b[l * 9216 + j];
    for (int ks = 0; ks < 8; ++ks) s += mp[(size_t)((l * 8 + ks) * 4 + b) * 9216 + j];
    mo[i] = s;
  }
}
__device__ __forceinline__ float ld_agent(const float* p) { return __hip_atomic_load(p, __ATOMIC_RELAXED, __HIP_MEMORY_SCOPE_AGENT); }
__device__ __forceinline__ int next_item(int* ctr) {
  __shared__ int s_item;
  __syncthreads();
  if (get_tid() == 0) s_item = atomicAdd(ctr, 1);
  __syncthreads();
  return s_item;
}

__device__ void modp_item(const Params& p, int item, unsigned char* smem) {
  int ks = item & 7, jc = (item >> 3) % 36, l = item / 288;
  float* sc = (float*)smem;
  int tid = get_tid();
  __syncthreads();
  for (int i = tid; i < 512; i += NT) { int b = i >> 7, k = i & 127; float cv = p.c[b * DM + ks * 128 + k]; sc[i] = cv / (1.f + expf(-cv)); }
  __syncthreads();
  int j = jc * 256 + tid;
  const float* w = p.ada_w + ((size_t)l * DM + ks * 128) * 9216 + j;
  float a0 = 0, a1 = 0, a2 = 0, a3 = 0;
#pragma unroll 8
  for (int k = 0; k < 128; ++k) { float wv = w[(size_t)k * 9216]; a0 += sc[k] * wv; a1 += sc[128 + k] * wv; a2 += sc[256 + k] * wv; a3 += sc[384 + k] * wv; }
  float* mp = (float*)(p.ws + OFF_MODP) + (size_t)((l * 8 + ks) * 4) * 9216 + j;
  mp[0] = a0; mp[9216] = a1; mp[2 * 9216] = a2; mp[3 * 9216] = a3;
}

__device__ __forceinline__ int win_map(int r) {
  if (r < 1152) return r;
  if (r < 2304) return 2316 + (r - 1152);
  if (r < 2560) return 1804 + (r - 2304);
  if (r < 2816) return 2060 + (r - 2560);
  if (r < 3200) return 1164 + (r - 2816);
  if (r < 3456) return 1548 + (r - 3200);
  if (r < 3840) return 3480 + (r - 3456);
  if (r < 3852) return 1152 + (r - 3840);
  if (r < 3864) return 3468 + (r - 3852);
  return -1;
}
#define NCONV_ITEMS 5472
__device__ void convert_item(const Params& p, int l, int idx, unsigned char* smem) {
  float* t = (float*)smem;
  int tid = get_tid();
  const float* src; u16* dst; int Nsrc, K, n0, k0, mode;
  u16* wt = (u16*)(p.ws + OFF_WT);
  if (idx < 2816) { int f = idx / 1408, r = idx % 1408; n0 = (r / 16) * 64; k0 = (r % 16) * 64; src = p.w13 + (size_t)(l * 2 + f) * 1024 * 5632; Nsrc = 5632; K = 1024; dst = wt + WT13_OFF(f); mode = 1; }
  else if (idx < 4224) { int q = idx - 2816; int f = q / 704, r = q % 704; n0 = (r / 44) * 64; k0 = (r % 44) * 64; src = p.w2 + (size_t)(l * 2 + f) * 2816 * 1024; Nsrc = 1024; K = 2816; dst = wt + WT2_OFF(f); mode = 0; }
  else if (idx < 5216) { int r = idx - 4224; n0 = (r / 16) * 64; k0 = (r % 16) * 64; src = p.w_in + (size_t)l * 1024 * 3864; Nsrc = 3864; K = 1024; dst = wt + WTIN_OFF; mode = 2; }
  else { int r = idx - 5216; n0 = (r / 16) * 64; k0 = (r % 16) * 64; src = p.w_out + (size_t)l * 1024 * 1024; Nsrc = 1024; K = 1024; dst = wt + WTOUT_OFF; mode = 0; }
  __syncthreads();
  {
    int c = tid & 63, kr = tid >> 6;
    int nd = n0 + c, ns;
    if (mode == 0) ns = nd;
    else if (mode == 1) { int grp = nd >> 6, w = nd & 63; ns = grp * 32 + (w & 31) + ((w & 32) ? 2816 : 0); }
    else ns = win_map(nd);
#pragma unroll 4
    for (int it = 0; it < 16; ++it) {
      int kk = it * 4 + kr;
      float v = (ns >= 0) ? src[(size_t)(k0 + kk) * Nsrc + ns] : 0.f;
      t[kk * 65 + c] = v;
    }
  }
  __syncthreads();
  {
    int n = tid >> 2, kq = tid & 3;
    unsigned pk[8];
#pragma unroll
    for (int i = 0; i < 8; ++i) {
      u16 lo = f2bf(t[(kq * 16 + 2 * i) * 65 + n]);
      u16 hi = f2bf(t[(kq * 16 + 2 * i + 1) * 65 + n]);
      pk[i] = (unsigned)lo | ((unsigned)hi << 16);
    }
    uint4* o = (uint4*)(dst + (size_t)(n0 + n) * K + k0 + kq * 16);
    o[0] = make_uint4(pk[0], pk[1], pk[2], pk[3]);
    o[1] = make_uint4(pk[4], pk[5], pk[6], pk[7]);
  }
}

__device__ void ln_phase(const Params& p, bool do_ln, int lg, int sg, bool do_a, int l2, int sub2) {
  int tid = get_tid(), lane = tid & 63;
  int gw = blockIdx.x * 4 + (tid >> 6), GW = gridDim.x * 4;
  int R = (NTOK + GW - 1) / GW;
  int r0 = gw * R, r1 = min(r0 + R, NTOK);
  const float* src = do_ln ? p.out : p.x;
  u16* A = (u16*)(p.ws + OFF_GDNI);
  float g[16], bb[16], sh[16], sc[16];
  if (do_ln) {
#pragma unroll
    for (int i = 0; i < 4; ++i)
#pragma unroll
      for (int e = 0; e < 4; ++e) { int col = i * 256 + lane * 4 + e; g[i * 4 + e] = p.ln_g[(lg * 3 + sg) * DM + col]; bb[i * 4 + e] = p.ln_b[(lg * 3 + sg) * DM + col]; }
  }
  int curb = -1;
  float xs[16];
#pragma unroll
  for (int i = 0; i < 16; ++i) xs[i] = 0.f;
  int xblk = -1;
  for (int r = r0; r < r1; ++r) {
    int b = r / SEQ;
    if (do_a && b != curb) {
      curb = b;
#pragma unroll
      for (int i = 0; i < 4; ++i)
#pragma unroll
        for (int e = 0; e < 4; ++e) { int col = i * 256 + lane * 4 + e; sh[i * 4 + e] = mod_get(p, l2, b, sub2 * 3072 + col); sc[i * 4 + e] = 1.f + mod_get(p, l2, b, sub2 * 3072 + 1024 + col); }
    }
    float v[16];
#pragma unroll
    for (int i = 0; i < 4; ++i) { float4 t = *(const float4*)(src + (size_t)r * DM + i * 256 + lane * 4); v[i * 4] = t.x; v[i * 4 + 1] = t.y; v[i * 4 + 2] = t.z; v[i * 4 + 3] = t.w; }
    if (do_ln) {
      float s = 0;
#pragma unroll
      for (int i = 0; i < 16; ++i) s += v[i];
#pragma unroll
      for (int o = 1; o < 64; o <<= 1) s += __shfl_xor(s, o);
      float mu = s * (1.f / 1024.f);
      float q = 0;
#pragma unroll
      for (int i = 0; i < 16; ++i) { float d = v[i] - mu; q += d * d; }
#pragma unroll
      for (int o = 1; o < 64; o <<= 1) q += __shfl_xor(q, o);
      float rs = rsqrtf(q * (1.f / 1024.f) + 1e-5f);
#pragma unroll
      for (int i = 0; i < 16; ++i) v[i] = (v[i] - mu) * rs * g[i] + bb[i];
#pragma unroll
      for (int i = 0; i < 4; ++i) *(float4*)(p.out + (size_t)r * DM + i * 256 + lane * 4) = make_float4(v[i * 4], v[i * 4 + 1], v[i * 4 + 2], v[i * 4 + 3]);
    }
    if (do_a && sub2 == 1) {
      u16* Alo = (u16*)(p.ws + OFF_ALO);
      int blk = r >> 8;
      if (blk != xblk) {
        if (xblk >= 0) {
          float* xb = (float*)(p.ws + OFF_XBAR) + (size_t)xblk * DM;
#pragma unroll
          for (int i = 0; i < 4; ++i)
#pragma unroll
            for (int e = 0; e < 4; ++e) { atomicAdd(xb + i * 256 + lane * 4 + e, xs[i * 4 + e]); xs[i * 4 + e] = 0.f; }
        }
        xblk = blk;
      }
#pragma unroll
      for (int i = 0; i < 4; ++i) {
        u16 lo[4];
#pragma unroll
        for (int e = 0; e < 4; ++e) {
          float xm = v[i * 4 + e] * sc[i * 4 + e] + sh[i * 4 + e];
          xs[i * 4 + e] += xm;
          lo[e] = f2bf(xm - bf2f(f2bf(xm)));
        }
        *(uint2*)(Alo + (size_t)r * DM + i * 256 + lane * 4) = make_uint2((unsigned)lo[0] | ((unsigned)lo[1] << 16), (unsigned)lo[2] | ((unsigned)lo[3] << 16));
      }
    }
    if (do_a) {
#pragma unroll
      for (int i = 0; i < 4; ++i) {
        u16 a0 = f2bf(v[i * 4] * sc[i * 4] + sh[i * 4]), a1 = f2bf(v[i * 4 + 1] * sc[i * 4 + 1] + sh[i * 4 + 1]);
        u16 a2 = f2bf(v[i * 4 + 2] * sc[i * 4 + 2] + sh[i * 4 + 2]), a3 = f2bf(v[i * 4 + 3] * sc[i * 4 + 3] + sh[i * 4 + 3]);
        *(uint2*)(A + (size_t)r * DM + i * 256 + lane * 4) = make_uint2((unsigned)a0 | ((unsigned)a1 << 16), (unsigned)a2 | ((unsigned)a3 << 16));
      }
    }
  }
  if (xblk >= 0) {
    float* xb = (float*)(p.ws + OFF_XBAR) + (size_t)xblk * DM;
#pragma unroll
    for (int i = 0; i < 4; ++i)
#pragma unroll
      for (int e = 0; e < 4; ++e) atomicAdd(xb + i * 256 + lane * 4 + e, xs[i * 4 + e]);
  }
}

__device__ void u_item(const Params& p, int l, int item, unsigned char* smem) {
  int h = item & 3, nb = (item >> 2) & 31, b = item >> 7, tid = get_tid();
  float* xb = (float*)smem; float* red = xb + 1024; float* kb = red + 256;
  const float* XB = (const float*)(p.ws + OFF_XBAR) + (size_t)(b * 32 + nb) * DM;
  const float* W = p.w_in + (size_t)l * 1024 * 3864;
  __syncthreads();
  for (int i = tid; i < 1024; i += NT) xb[i] = XB[i] * (1.f / 256.f);
  __syncthreads();
  {
    int j = tid & 63, kq = tid >> 6;
    const float* wk = W + (size_t)(kq * 256) * 3864 + 1804 + h * 64 + j;
    float s = 0.f;
#pragma unroll 8
    for (int k = 0; k < 256; ++k) s += xb[kq * 256 + k] * wk[(size_t)k * 3864];
    red[kq * 64 + j] = s;
  }
  __syncthreads();
  if (tid < 64) kb[tid] = red[tid] + red[64 + tid] + red[128 + tid] + red[192 + tid];
  __syncthreads();
  u16* UH = (u16*)(p.ws + OFF_UH) + ((size_t)b * 128 + h * 32 + nb) * 1024;
  u16* UL = (u16*)(p.ws + OFF_UL) + ((size_t)b * 128 + h * 32 + nb) * 1024;
  for (int i = 0; i < 4; ++i) {
    int k = i * 256 + tid;
    const float* wq = W + (size_t)k * 3864 + 1548 + h * 64;
    float s = 0.f;
#pragma unroll
    for (int j = 0; j < 64; j += 4) { float4 wv = *(const float4*)(wq + j); s += wv.x * kb[j] + wv.y * kb[j + 1] + wv.z * kb[j + 2] + wv.w * kb[j + 3]; }
    u16 hi = f2bf(s);
    UH[k] = hi; UL[k] = f2bf(s - bf2f(hi));
  }
}

enum { EPI_SWIGLU = 0, EPI_RES = 1, EPI_PROJ = 2 };
struct EpiArgs { const float* xres; int l, sub; float gs; };

__device__ __forceinline__ void gemm_stage(const u16* A, int lda, const u16* Bt, int K, int brow, int bcol, int kt, unsigned char* buf) {
  int tid = get_tid();
#pragma unroll
  for (int i = 0; i < 4; ++i) {
    int pidx = i * 256 + tid; int r = pidx >> 3, cp = pidx & 7; int cl = cp ^ ((r >> 1) & 7);
    __builtin_amdgcn_global_load_lds((const unsigned*)(A + (size_t)(brow + r) * lda + kt * 64 + cl * 8), (unsigned*)(buf + pidx * 16), 16, 0, 0);
  }
#pragma unroll
  for (int i = 0; i < 4; ++i) {
    int pidx = i * 256 + tid; int r = pidx >> 3, cp = pidx & 7; int cl = cp ^ ((r >> 1) & 7);
    __builtin_amdgcn_global_load_lds((const unsigned*)(Bt + (size_t)(bcol + r) * K + kt * 64 + cl * 8), (unsigned*)(buf + 16384 + pidx * 16), 16, 0, 0);
  }
}
__device__ __forceinline__ bf16x8 ldfrag_sw(const unsigned char* buf, int row, int cl) {
  return *(const bf16x8*)(buf + row * 128 + ((cl ^ ((row >> 1) & 7)) << 4));
}

template <int MODE>
__device__ void gemm_phase(const Params& p, const u16* A, int lda, const u16* Bt, int K, int ntn, EpiArgs ea, unsigned char* smem, int nt_fixed = -1, bool xcd_patch = false) {
  int tid = get_tid(), wid = tid >> 6, lane = tid & 63, wr = wid >> 1, wc = wid & 1, fr = lane & 15, fq = lane >> 4;
  int ntiles = (nt_fixed >= 0) ? 256 : 256 * ntn, nk = K / 64;
  int tstart = (nt_fixed >= 0) ? (int)((blockIdx.x + gridDim.x - (256 % gridDim.x)) % gridDim.x) : (int)blockIdx.x;
  bool patch = xcd_patch && nt_fixed < 0 && (gridDim.x & 7) == 0;
  int px = blockIdx.x & 7, pn0 = (ntn * (px & 3)) >> 2, png = ((ntn * ((px & 3) + 1)) >> 2) - pn0;
  int tstep = gridDim.x;
  if (patch) { tstart = blockIdx.x >> 3; ntiles = 128 * png; tstep = gridDim.x >> 3; }
  for (int t = tstart; t < ntiles; t += tstep) {
    int g = t / (8 * ntn), r = t % (8 * ntn);
    int mt = g * 8 + (r & 7), nt = r >> 3;
    if (nt_fixed >= 0) { mt = t; nt = nt_fixed; }
    if (patch) { mt = (px >> 2) * 128 + t / png; nt = pn0 + t % png; }
    int brow = mt * 128, bcol = nt * 128;
    f32x4 acc[4][4];
#pragma unroll
    for (int m = 0; m < 4; ++m)
#pragma unroll
      for (int n = 0; n < 4; ++n) acc[m][n] = (f32x4){0.f, 0.f, 0.f, 0.f};
    int b = brow / SEQ;
    const u16* B0 = Bt; const u16* B2 = Bt; const u16* A1 = A; int bc = bcol, npass = 1;
    if (MODE == EPI_PROJ && nt == 31) {
      B0 = (const u16*)(p.ws + OFF_UH) + (size_t)b * 128 * 1024; B2 = (const u16*)(p.ws + OFF_UL) + (size_t)b * 128 * 1024;
      A1 = (const u16*)(p.ws + OFF_ALO); bc = 0; npass = 3;
    }
    int nkt = nk * npass;
    __syncthreads();
    gemm_stage(A, lda, B0, K, brow, bc, 0, smem);
    for (int kt = 0; kt < nkt; ++kt) {
      asm volatile("s_waitcnt vmcnt(0)" ::: "memory");
      __syncthreads();
      unsigned char* cur = smem + (kt & 1) * 32768;
      if (kt + 1 < nkt) {
        int ps = (kt + 1) / nk, kk = (kt + 1) - ps * nk;
        gemm_stage(ps == 1 ? A1 : A, lda, ps == 2 ? B2 : B0, K, brow, bc, kk, smem + ((kt + 1) & 1) * 32768);
      }
#pragma unroll
      for (int ks = 0; ks < 2; ++ks) {
        bf16x8 af[4], bfr[4];
#pragma unroll
        for (int m = 0; m < 4; ++m) af[m] = ldfrag_sw(cur, wr * 64 + m * 16 + fr, ks * 4 + fq);
#pragma unroll
        for (int n = 0; n < 4; ++n) bfr[n] = ldfrag_sw(cur + 16384, wc * 64 + n * 16 + fr, ks * 4 + fq);
#pragma unroll
        for (int m = 0; m < 4; ++m)
#pragma unroll
          for (int n = 0; n < 4; ++n) acc[m][n] = mfma16(af[m], bfr[n], acc[m][n]);
      }
    }
    if (MODE == EPI_SWIGLU) {
      u16* hbuf = (u16*)(p.ws + OFF_PROJ);
#pragma unroll
      for (int m = 0; m < 4; ++m)
#pragma unroll
        for (int n = 0; n < 2; ++n) {
          int hid = (nt * 2 + wc) * 32 + n * 16 + fr;
#pragma unroll
          for (int j = 0; j < 4; ++j) {
            int row = brow + wr * 64 + m * 16 + fq * 4 + j;
            float a = acc[m][n][j], bv = acc[m][n + 2][j];
            hbuf[(size_t)row * DFF + hid] = f2bf(siluf(a) * bv);
          }
        }
    } else if (MODE == EPI_RES) {
#pragma unroll
      for (int n = 0; n < 4; ++n) {
        int col = bcol + wc * 64 + n * 16 + fr;
        float gate = ea.gs * (1.f + mod_get(p, ea.l, b, ea.sub * 3072 + 2048 + col));
#pragma unroll
        for (int m = 0; m < 4; ++m)
#pragma unroll
          for (int j = 0; j < 4; ++j) {
            int row = brow + wr * 64 + m * 16 + fq * 4 + j;
            size_t idx = (size_t)row * DM + col;
            p.out[idx] = ALPHA_F * ea.xres[idx] + gate * acc[m][n][j];
          }
      }
    } else {
      u16* proj = (u16*)(p.ws + OFF_PROJ);
      if (nt == 31) {
        float* gm = (float*)(p.ws + OFF_GM);
#pragma unroll
        for (int n = 0; n < 4; ++n) {
          int gc = wc * 64 + n * 16 + fr;
#pragma unroll
          for (int m = 0; m < 4; ++m)
#pragma unroll
            for (int j = 0; j < 4; ++j) { int row = brow + wr * 64 + m * 16 + fq * 4 + j; gm[(size_t)row * 128 + gc] = acc[m][n][j]; }
        }
      } else if (nt == 30) {
        float* gates = (float*)(p.ws + OFF_GATES);
#pragma unroll
        for (int n = 0; n < 4; ++n) {
          int gc = wc * 64 + n * 16 + fr;
          if (gc < 24) {
#pragma unroll
            for (int m = 0; m < 4; ++m)
#pragma unroll
              for (int j = 0; j < 4; ++j) { int row = brow + wr * 64 + m * 16 + fq * 4 + j; gates[(size_t)row * 24 + gc] = acc[m][n][j]; }
          }
        }
      } else if ((nt >= 15 && nt <= 17) || nt == 20 || nt == 21) {
        bool isc = nt < 18;
        u16* vt = (u16*)(p.ws + (isc ? OFF_VCT : OFF_VBT));
        int H = isc ? 6 : 4, cb = isc ? 1920 : 2560;
#pragma unroll
        for (int n = 0; n < 4; ++n) {
          int cc = bcol + wc * 64 + n * 16 + fr - cb; int head = cc >> 6, e = cc & 63;
#pragma unroll
          for (int m = 0; m < 4; ++m) {
            int tt = (brow - b * SEQ) + wr * 64 + m * 16 + fq * 4;
            u16 v0 = f2bf(acc[m][n][0]), v1 = f2bf(acc[m][n][1]), v2 = f2bf(acc[m][n][2]), v3 = f2bf(acc[m][n][3]);
            *(uint2*)(vt + ((size_t)(b * H + head) * 64 + e) * SEQ + tt) = make_uint2((unsigned)v0 | ((unsigned)v1 << 16), (unsigned)v2 | ((unsigned)v3 << 16));
          }
        }
      } else {
        int shift = nt < 15 ? 0 : (nt < 20 ? 384 : 640);
#pragma unroll
        for (int n = 0; n < 4; ++n) {
          int pc = bcol + wc * 64 + n * 16 + fr - shift;
#pragma unroll
          for (int m = 0; m < 4; ++m)
#pragma unroll
            for (int j = 0; j < 4; ++j) { int row = brow + wr * 64 + m * 16 + fq * 4 + j; proj[(size_t)row * PROJ_LD + pc] = f2bf(acc[m][n][j]); }
        }
      }
    }
  }
}

__device__ void mchain_item(const Params& p, int l, int bh, unsigned char* smem) {
  int b = bh / 6, h = bh % 6, tid = get_tid();
  float* bLs = (float*)smem; float* mws = bLs + 128;
  const float* gates = (const float*)(p.ws + OFF_GATES);
  __syncthreads();
  if (tid < 128) {
    float ib = p.mlstm_i_bias[l * 6 + h], fb = p.mlstm_f_bias[l * 6 + h];
    float bc = 0.f, mx = -INFINITY;
    size_t row = (size_t)b * SEQ + tid * 64;
    for (int s = 0; s < 64; ++s) {
      float ip = ld_agent(&gates[(row + s) * 24 + 12 + h]) + ib;
      float lf = logsigf(ld_agent(&gates[(row + s) * 24 + 18 + h]) + fb);
      bc += lf; mx = fmaxf(mx, ip - bc);
    }
    bLs[tid] = bc; mws[tid] = bc + mx;
  }
  __syncthreads();
  if (tid == 0) {
    float* mch = (float*)(p.ws + OFF_MCH) + bh * 129;
    float m = 0.f;
    for (int n = 0; n < 128; ++n) { mch[n] = m; m = fmaxf(bLs[n] + m, mws[n]); }
    mch[128] = m;
  }
}

__device__ void kmean_item(const Params& p, int item, unsigned char* smem) {
  int nb = item & 31, bh = item >> 5, b = bh >> 2, h = bh & 3, tid = get_tid();
  float* red = (float*)smem;
  const u16* proj = (const u16*)(p.ws + OFF_PROJ);
  int d = tid & 63, part = tid >> 6;
  float s = 0.f;
  for (int k = 0; k < 64; ++k) s += bf2f(proj[((size_t)b * SEQ + nb * 256 + part * 64 + k) * PROJ_LD + 1920 + h * 64 + d]);
  __syncthreads();
  red[tid] = s;
  __syncthreads();
  if (tid < 64) ((float*)(p.ws + OFF_KMEAN))[(size_t)item * 64 + tid] = (red[tid] + red[64 + tid] + red[128 + tid] + red[192 + tid]) * (1.f / 256.f);
}

__device__ __forceinline__ void conv_silu_tile(const u16* proj, int b, int t0, int pcol, const float* cw, int cwld, int ccol, float* dst, float post) {
  int tid = get_tid(), d = tid & 63, rg = tid >> 6;
  float w0 = cw[ccol + d], w1 = cw[cwld + ccol + d], w2 = cw[2 * cwld + ccol + d], w3 = cw[3 * cwld + ccol + d];
  int tl0 = t0 + rg * 16;
  const u16* base = proj + (size_t)b * SEQ * PROJ_LD + pcol + d;
  float xm3 = (tl0 - 3 >= 0) ? bf2f(base[(size_t)(tl0 - 3) * PROJ_LD]) : 0.f;
  float xm2 = (tl0 - 2 >= 0) ? bf2f(base[(size_t)(tl0 - 2) * PROJ_LD]) : 0.f;
  float xm1 = (tl0 - 1 >= 0) ? bf2f(base[(size_t)(tl0 - 1) * PROJ_LD]) : 0.f;
  float xr[16];
#pragma unroll
  for (int i = 0; i < 16; ++i) xr[i] = bf2f(base[(size_t)(tl0 + i) * PROJ_LD]);
#pragma unroll
  for (int i = 0; i < 16; ++i) {
    float x0 = xr[i];
    float y = w0 * xm3 + w1 * xm2 + w2 * xm1 + w3 * x0;
    dst[(rg * 16 + i) * 65 + d] = siluf(y) * post;
    xm3 = xm2; xm2 = xm1; xm1 = x0;
  }
}

__device__ void gdn_local_item(const Params& p, int l, int item, unsigned char* smem) {
  int n = item & 127, bh = item >> 7, b = bh / 6, h = bh % 6, tid = get_tid();
  float* qs = (float*)smem; float* ks = qs + 64 * 65; float* vs = ks + 64 * 65; float* As = vs + 64 * 65;
  float* Gs = As + 64 * 64; float* betas = Gs + 64; float* eGs = betas + 64;
  const u16* proj = (const u16*)(p.ws + OFF_PROJ);
  const float* gates = (const float*)(p.ws + OFF_GATES);
  u16* outb = (u16*)(p.ws + OFF_GDNI) + (size_t)item * GDNI_STRIDE;
  u16 *w_o = outb, *u_o = outb + 4096, *at_o = outb + 8192, *qd_o = outb + 12288, *kd_o = outb + 16384;
  int t0 = n * 64;
  __syncthreads();
  const float* cw = p.gdn_conv + (size_t)l * 4 * 1152;
  conv_silu_tile(proj, b, t0, h * 64, cw, 1152, h * 64, qs, 1.f);
  conv_silu_tile(proj, b, t0, 384 + h * 64, cw, 1152, 384 + h * 64, ks, 1.f);
  conv_silu_tile(proj, b, t0, 768 + h * 64, cw, 1152, 768 + h * 64, vs, 1.f);
  if (tid < 64) {
    size_t row = (size_t)b * SEQ + t0 + tid;
    float a = ld_agent(&gates[row * 24 + h]), br = ld_agent(&gates[row * 24 + 6 + h]);
    float g = -expf(p.gdn_a_log[l * 6 + h]) * softplusf(a + p.gdn_dt_bias[l * 6 + h]);
    float beta = 1.f / (1.f + expf(-br));
    float G = g;
#pragma unroll
    for (int o = 1; o < 64; o <<= 1) { float t = __shfl_up(G, o); if (tid >= o) G += t; }
    Gs[tid] = G; betas[tid] = beta; eGs[tid] = expf(G);
  }
  __syncthreads();
  {
    int row = tid >> 2, part = tid & 3;
    float sq = 0.f, sk = 0.f;
#pragma unroll
    for (int i = 0; i < 16; ++i) { float a = qs[row * 65 + part * 16 + i], c = ks[row * 65 + part * 16 + i]; sq += a * a; sk += c * c; }
    sq += __shfl_xor(sq, 1); sq += __shfl_xor(sq, 2); sk += __shfl_xor(sk, 1); sk += __shfl_xor(sk, 2);
    float rq = rsqrtf(sq + 1e-6f) * 0.125f, rk = rsqrtf(sk + 1e-6f);
#pragma unroll
    for (int i = 0; i < 16; ++i) { qs[row * 65 + part * 16 + i] *= rq; ks[row * 65 + part * 16 + i] *= rk; }
  }
  __syncthreads();
  {
    int ti = tid >> 4, tj = tid & 15;
    float kk[4][4], qk[4][4];
#pragma unroll
    for (int a = 0; a < 4; ++a)
#pragma unroll
      for (int c = 0; c < 4; ++c) { kk[a][c] = 0.f; qk[a][c] = 0.f; }
    if (tj <= ti) {
      for (int d = 0; d < 64; ++d) {
        float ki[4], qi[4], kj[4];
#pragma unroll
        for (int a = 0; a < 4; ++a) { ki[a] = ks[(ti * 4 + a) * 65 + d]; qi[a] = qs[(ti * 4 + a) * 65 + d]; kj[a] = ks[(tj * 4 + a) * 65 + d]; }
#pragma unroll
        for (int a = 0; a < 4; ++a)
#pragma unroll
          for (int c = 0; c < 4; ++c) { kk[a][c] += ki[a] * kj[c]; qk[a][c] += qi[a] * kj[c]; }
      }
    }
#pragma unroll
    for (int a = 0; a < 4; ++a) {
      int i = ti * 4 + a;
      u16 av[4];
#pragma unroll
      for (int c = 0; c < 4; ++c) {
        int j = tj * 4 + c;
        float dec = (j <= i) ? expf(Gs[i] - Gs[j]) : 0.f;
        As[i * 64 + j] = (j < i) ? betas[i] * kk[a][c] * dec : 0.f;
        av[c] = f2bf((j <= i) ? qk[a][c] * dec : 0.f);
      }
      *(uint2*)(at_o + i * 64 + tj * 4) = make_uint2((unsigned)av[0] | ((unsigned)av[1] << 16), (unsigned)av[2] | ((unsigned)av[3] << 16));
    }
  }
  __syncthreads();
  {
    int d = tid & 63, ig = tid >> 6;
    for (int ii = 0; ii < 16; ++ii) { int i = ig * 16 + ii; qd_o[i * 64 + d] = f2bf(qs[i * 65 + d] * eGs[i]); }
    int li = tid & 63;
    float kd = expf(Gs[63] - Gs[li]);
    for (int dd = 0; dd < 16; ++dd) { int dcol = ig * 16 + dd; kd_o[dcol * 64 + li] = f2bf(ks[li * 65 + dcol] * kd); }
    if (tid == 0) ((float*)(p.ws + OFF_GL))[item] = eGs[63];
  }
  __syncthreads();
  {
    int d = tid & 63, ig = tid >> 6;
    for (int ii = 0; ii < 16; ++ii) { int i = ig * 16 + ii; float bt = betas[i]; vs[i * 65 + d] *= bt; ks[i * 65 + d] *= bt * eGs[i]; }
  }
  __syncthreads();
  {
    int c = tid >> 1, half = tid & 1, cc = c & 63;
    float* buf = (c < 64) ? vs : ks;
    for (int i = 1; i < 64; ++i) {
      float s = 0.f;
      float s1 = 0.f; int j = half;
      for (; j + 2 < i; j += 4) { s += As[i * 64 + j] * buf[j * 65 + cc]; s1 += As[i * 64 + j + 2] * buf[(j + 2) * 65 + cc]; }
      for (; j < i; j += 2) s += As[i * 64 + j] * buf[j * 65 + cc];
      s += s1;
      s += __shfl_xor(s, 1);
      if (half == 0) buf[i * 65 + cc] -= s;
    }
  }
  __syncthreads();
  {
    int d = tid & 63, ig = tid >> 6;
    for (int ii = 0; ii < 16; ++ii) { int i = ig * 16 + ii; u_o[i * 64 + d] = f2bf(vs[i * 65 + d]); w_o[i * 64 + d] = f2bf(ks[i * 65 + d]); }
  }
}

__device__ void gdn_scan_item(const Params& p, int l, int bh, unsigned char* smem) {
  int b = bh / 6, h = bh % 6, tid = get_tid(), wid = tid >> 6, lane = tid & 63, fr = lane & 15, fq = lane >> 4;
  u16* Ws = (u16*)smem; u16* Us = Ws + 64 * 72; u16* ATs = Us + 64 * 72; u16* QDs = ATs + 64 * 72; u16* KDs = QDs + 64 * 72;
  u16* STs = KDs + 64 * 72; u16* VTs = STs + 64 * 72;
  u16* proj = (u16*)(p.ws + OFF_PROJ);
  const u16* gi = (const u16*)(p.ws + OFF_GDNI) + (size_t)bh * 128 * GDNI_STRIDE;
  const float* glast = (const float*)(p.ws + OFF_GL) + bh * 128;
  const float* gnorm = p.gdn_norm + l * 64;
  f32x4 st[4];
#pragma unroll
  for (int i = 0; i < 4; ++i) st[i] = (f32x4){0.f, 0.f, 0.f, 0.f};
  __syncthreads();
  for (int i = tid; i < 64 * 72; i += NT) STs[i] = 0;
  u32x4 pre[10], prb[10];
#pragma unroll
  for (int i = 0; i < 10; ++i) pre[i] = *(const u32x4*)(gi + (size_t)(i * 256 + tid) * 8);
#pragma unroll
  for (int i = 0; i < 10; ++i) { int q = i * 256 + tid; int mat = q >> 9, r = (q >> 3) & 63, c = q & 7; *(u32x4*)(Ws + mat * 64 * 72 + r * 72 + c * 8) = pre[i]; }
  __syncthreads();
  float gn[4];
#pragma unroll
  for (int nt = 0; nt < 4; ++nt) gn[nt] = gnorm[nt * 16 + fr];
  {
    const u16* g1 = gi + (size_t)GDNI_STRIDE;
#pragma unroll
    for (int i = 0; i < 10; ++i) pre[i] = *(const u32x4*)(g1 + (size_t)(i * 256 + tid) * 8);
  }
  auto step = [&](int n, u32x4 (&LD)[10], u32x4 (&WR)[10]) {
    if (n + 2 < 128) {
      const u16* g2 = gi + (size_t)(n + 2) * GDNI_STRIDE;
#pragma unroll
      for (int i = 0; i < 10; ++i) LD[i] = *(const u32x4*)(g2 + (size_t)(i * 256 + tid) * 8);
    }
    float gl = ld_agent(&glast[n]);
    float zr[4][4];
#pragma unroll
    for (int j = 0; j < 4; ++j) {
      size_t row = (size_t)b * SEQ + n * 64 + 16 * wid + fq * 4 + j;
#pragma unroll
      for (int nt = 0; nt < 4; ++nt) zr[j][nt] = bf2f(proj[row * PROJ_LD + 2176 + h * 64 + nt * 16 + fr]);
    }
    f32x4 c1[4];
#pragma unroll
    for (int i = 0; i < 4; ++i) c1[i] = (f32x4){0.f, 0.f, 0.f, 0.f};
#pragma unroll
    for (int ks = 0; ks < 2; ++ks) {
      bf16x8 a = ldfrag72(STs, 16 * wid + fr, ks, fq);
#pragma unroll
      for (int nt = 0; nt < 4; ++nt) c1[nt] = mfma16(a, ldfrag72(Ws, nt * 16 + fr, ks, fq), c1[nt]);
    }
#pragma unroll
    for (int nt = 0; nt < 4; ++nt) {
      int l_ = nt * 16 + fr;
      uint2 u4 = *(const uint2*)(Us + l_ * 72 + 16 * wid + fq * 4);
      u16 uu[4] = {(u16)(u4.x & 0xffffu), (u16)(u4.x >> 16), (u16)(u4.y & 0xffffu), (u16)(u4.y >> 16)};
#pragma unroll
      for (int j = 0; j < 4; ++j) { int e = 16 * wid + fq * 4 + j; VTs[e * 72 + l_] = f2bf(bf2f(uu[j]) - c1[nt][j]); }
    }
    __syncthreads();
    f32x4 o[4];
#pragma unroll
    for (int i = 0; i < 4; ++i) o[i] = (f32x4){0.f, 0.f, 0.f, 0.f};
#pragma unroll
    for (int ks = 0; ks < 2; ++ks) {
      bf16x8 a = ldfrag72(QDs, 16 * wid + fr, ks, fq);
#pragma unroll
      for (int nt = 0; nt < 4; ++nt) o[nt] = mfma16(a, ldfrag72(STs, nt * 16 + fr, ks, fq), o[nt]);
    }
#pragma unroll
    for (int ks = 0; ks < 2; ++ks) {
      bf16x8 a = ldfrag72(ATs, 16 * wid + fr, ks, fq);
#pragma unroll
      for (int nt = 0; nt < 4; ++nt) o[nt] = mfma16(a, ldfrag72(VTs, nt * 16 + fr, ks, fq), o[nt]);
    }
#pragma unroll
    for (int j = 0; j < 4; ++j) {
      float ss = o[0][j] * o[0][j] + o[1][j] * o[1][j] + o[2][j] * o[2][j] + o[3][j] * o[3][j];
      ss = red16_sum(ss);
      float rms = rsqrtf(ss * (1.f / 64.f) + 1e-6f);
      size_t row = (size_t)b * SEQ + n * 64 + 16 * wid + fq * 4 + j;
#pragma unroll
      for (int nt = 0; nt < 4; ++nt) {
        size_t idx = row * PROJ_LD + 2176 + h * 64 + nt * 16 + fr;
        float z = zr[j][nt];
        proj[idx] = f2bf(o[nt][j] * rms * gn[nt] * siluf(z));
      }
    }
#pragma unroll
    for (int nt = 0; nt < 4; ++nt) { st[nt][0] *= gl; st[nt][1] *= gl; st[nt][2] *= gl; st[nt][3] *= gl; }
#pragma unroll
    for (int ks = 0; ks < 2; ++ks) {
      bf16x8 a = ldfrag72(VTs, 16 * wid + fr, ks, fq);
#pragma unroll
      for (int nt = 0; nt < 4; ++nt) st[nt] = mfma16(a, ldfrag72(KDs, nt * 16 + fr, ks, fq), st[nt]);
    }
    __syncthreads();
#pragma unroll
    for (int nt = 0; nt < 4; ++nt)
#pragma unroll
      for (int j = 0; j < 4; ++j) STs[(16 * wid + fq * 4 + j) * 72 + nt * 16 + fr] = f2bf(st[nt][j]);
    if (n + 1 < 128) {
#pragma unroll
      for (int i = 0; i < 10; ++i) { int q = i * 256 + tid; int mat = q >> 9, r = (q >> 3) & 63, c = q & 7; *(u32x4*)(Ws + mat * 64 * 72 + r * 72 + c * 8) = WR[i]; }
    }
    __syncthreads();
  };
  for (int n = 0; n < 128; n += 2) { step(n, prb, pre); step(n + 1, pre, prb); }
}

__device__ void mlstm_local_item(const Params& p, int l, int item, unsigned char* smem) {
  int n = item & 127, bh = item >> 7, b = bh / 6, h = bh % 6, tid = get_tid();
  float* qs = (float*)smem; float* ks = qs + 64 * 65;
  float* bcs = ks + 64 * 65; float* ips = bcs + 64; float* mts = ips + 64; float* sws = mts + 64;
  const u16* proj = (const u16*)(p.ws + OFF_PROJ);
  const float* gates = (const float*)(p.ws + OFF_GATES);
  unsigned char* ob = p.ws + OFF_MLI + (size_t)item * MLI_STRIDE;
  u16 *qc_o = (u16*)ob, *P_o = qc_o + 4096, *sk_o = P_o + 4096;
  float* vec = (float*)(ob + 24576);
  const float* mch = (const float*)(p.ws + OFF_MCH) + bh * 129;
  int t0 = n * 64;
  __syncthreads();
  const float* cw = p.mlstm_conv + (size_t)l * 4 * 768;
  conv_silu_tile(proj, b, t0, 1152 + h * 64, cw, 768, h * 64, qs, 1.f);
  conv_silu_tile(proj, b, t0, 1536 + h * 64, cw, 768, 384 + h * 64, ks, 0.125f);
  if (tid < 64) {
    size_t row = (size_t)b * SEQ + t0 + tid;
    float ip = ld_agent(&gates[row * 24 + 12 + h]) + p.mlstm_i_bias[l * 6 + h];
    float lf = logsigf(ld_agent(&gates[row * 24 + 18 + h]) + p.mlstm_f_bias[l * 6 + h]);
    float bc = lf;
#pragma unroll
    for (int o = 1; o < 64; o <<= 1) { float t = __shfl_up(bc, o); if (tid >= o) bc += t; }
    float pm = ip - bc;
#pragma unroll
    for (int o = 1; o < 64; o <<= 1) { float t = __shfl_up(pm, o); if (tid >= o) pm = fmaxf(pm, t); }
    float m_in = ld_agent(&mch[n]), m_new = ld_agent(&mch[n + 1]);
    float inter = bc + m_in;
    float mt = fmaxf(inter, bc + pm);
    float bL = __shfl(bc, 63);
    float wend = bL - bc + ip;
    bcs[tid] = bc; ips[tid] = ip; mts[tid] = mt; sws[tid] = expf(wend - m_new);
    vec[tid] = expf(inter - mt);
    vec[64 + tid] = expf(-mt);
    if (tid == 0) vec[256] = expf(bL + m_in - m_new);
  }
  __syncthreads();
  {
    int ti = tid >> 4, tj = tid & 15;
    float qk[4][4];
#pragma unroll
    for (int a = 0; a < 4; ++a)
#pragma unroll
      for (int c = 0; c < 4; ++c) qk[a][c] = 0.f;
    if (tj <= ti) {
      for (int d = 0; d < 64; ++d) {
        float qi[4], kj[4];
#pragma unroll
        for (int a = 0; a < 4; ++a) { qi[a] = qs[(ti * 4 + a) * 65 + d]; kj[a] = ks[(tj * 4 + a) * 65 + d]; }
#pragma unroll
        for (int a = 0; a < 4; ++a)
#pragma unroll
          for (int c = 0; c < 4; ++c) qk[a][c] += qi[a] * kj[c];
      }
    }
#pragma unroll
    for (int a = 0; a < 4; ++a) {
      int i = ti * 4 + a;
      u16 pv[4]; float rs = 0.f;
#pragma unroll
      for (int c = 0; c < 4; ++c) {
        int j = tj * 4 + c;
        float pe = (j <= i) ? qk[a][c] * expf(bcs[i] - bcs[j] + ips[j] - mts[i]) : 0.f;
        rs += pe; pv[c] = f2bf(pe);
      }
      *(uint2*)(P_o + i * 64 + tj * 4) = make_uint2((unsigned)pv[0] | ((unsigned)pv[1] << 16), (unsigned)pv[2] | ((unsigned)pv[3] << 16));
      rs = red16_sum(rs);
      if (tj == 0) vec[128 + i] = rs;
    }
  }
  {
    int d = tid & 63, ig = tid >> 6;
    for (int ii = 0; ii < 16; ++ii) { int i = ig * 16 + ii; qc_o[i * 64 + d] = f2bf(qs[i * 65 + d]); }
    int li = tid & 63;
    float sw = sws[li];
    for (int dd = 0; dd < 16; ++dd) { int dcol = ig * 16 + dd; sk_o[dcol * 64 + li] = f2bf(sw * ks[li * 65 + dcol]); }
    if (tid < 64) {
      float s = 0.f;
      for (int i = 0; i < 64; ++i) s += sws[i] * ks[i * 65 + tid];
      vec[192 + tid] = s;
    }
  }
}

__device__ void mlstm_scan_item(const Params& p, int l, int bh, unsigned char* smem) {
  int b = bh / 6, h = bh % 6, tid = get_tid(), wid = tid >> 6, lane = tid & 63, fr = lane & 15, fq = lane >> 4;
  u16* QCs = (u16*)smem; u16* Ps = QCs + 64 * 72; u16* SKs = Ps + 64 * 72; u16* VTs = SKs + 64 * 72; u16* CTs = VTs + 64 * 72;
  float* nvec = (float*)(CTs + 64 * 72); float* qn = nvec + 64; float* vecs = qn + 64;
  u16* proj = (u16*)(p.ws + OFF_PROJ);
  const unsigned char* mi = p.ws + OFF_MLI + (size_t)bh * 128 * MLI_STRIDE;
  const u16* vct = (const u16*)(p.ws + OFF_VCT) + (size_t)bh * 64 * SEQ;
  const float* mnorm = p.mlstm_norm + l * 384 + h * 64;
  f32x4 ct[4];
#pragma unroll
  for (int i = 0; i < 4; ++i) ct[i] = (f32x4){0.f, 0.f, 0.f, 0.f};
  __syncthreads();
  for (int i = tid; i < 64 * 72; i += NT) CTs[i] = 0;
  if (tid < 64) nvec[tid] = 0.f;
  u32x4 pre[8], prb[8]; f32x4 prev = (f32x4){0.f, 0.f, 0.f, 0.f}, prvb = (f32x4){0.f, 0.f, 0.f, 0.f};
  {
    const u16* g2 = (const u16*)mi;
#pragma unroll
    for (int i = 0; i < 6; ++i) pre[i] = *(const u32x4*)(g2 + (size_t)(i * 256 + tid) * 8);
#pragma unroll
    for (int i = 0; i < 2; ++i) { int q = i * 256 + tid; int r = q >> 3, c = q & 7; pre[6 + i] = *(const u32x4*)(vct + (size_t)r * SEQ + c * 8); }
    if (tid < 80) prev = *(const f32x4*)(mi + 24576 + tid * 16);
#pragma unroll
    for (int i = 0; i < 6; ++i) { int q = i * 256 + tid; int mat = q >> 9, r = (q >> 3) & 63, c = q & 7; *(u32x4*)(QCs + mat * 64 * 72 + r * 72 + c * 8) = pre[i]; }
#pragma unroll
    for (int i = 0; i < 2; ++i) { int q = i * 256 + tid; int r = q >> 3, c = q & 7; *(u32x4*)(VTs + r * 72 + c * 8) = pre[6 + i]; }
    if (tid < 80) *(f32x4*)(vecs + tid * 4) = prev;
  }
  __syncthreads();
  float mn[4];
#pragma unroll
  for (int nt = 0; nt < 4; ++nt) mn[nt] = mnorm[nt * 16 + fr];
  {
    const unsigned char* m1 = mi + (size_t)MLI_STRIDE;
    const u16* g1 = (const u16*)m1;
#pragma unroll
    for (int i = 0; i < 6; ++i) pre[i] = *(const u32x4*)(g1 + (size_t)(i * 256 + tid) * 8);
#pragma unroll
    for (int i = 0; i < 2; ++i) { int q = i * 256 + tid; int r = q >> 3, c = q & 7; pre[6 + i] = *(const u32x4*)(vct + (size_t)r * SEQ + 64 + c * 8); }
    if (tid < 80) prev = *(const f32x4*)(m1 + 24576 + tid * 16);
  }
  auto step = [&](int n, u32x4 (&LD)[8], f32x4& LDV, u32x4 (&WR)[8], f32x4& WRV) {
    if (n + 2 < 128) {
      const unsigned char* m2 = mi + (size_t)(n + 2) * MLI_STRIDE;
      const u16* g2 = (const u16*)m2;
#pragma unroll
      for (int i = 0; i < 6; ++i) LD[i] = *(const u32x4*)(g2 + (size_t)(i * 256 + tid) * 8);
#pragma unroll
      for (int i = 0; i < 2; ++i) { int q = i * 256 + tid; int r = q >> 3, c = q & 7; LD[6 + i] = *(const u32x4*)(vct + (size_t)r * SEQ + (n + 2) * 64 + c * 8); }
      if (tid < 80) LDV = *(const f32x4*)(m2 + 24576 + tid * 16);
    }
    float orw[4][4];
#pragma unroll
    for (int j = 0; j < 4; ++j) {
      size_t row = (size_t)b * SEQ + n * 64 + 16 * wid + fq * 4 + j;
#pragma unroll
      for (int nt = 0; nt < 4; ++nt) orw[j][nt] = bf2f(proj[row * PROJ_LD + 2816 + h * 64 + nt * 16 + fr]);
    }
    {
      int l_ = tid >> 2, part = tid & 3;
      float s = 0.f;
#pragma unroll
      for (int i = 0; i < 16; ++i) s += bf2f(QCs[l_ * 72 + part * 16 + i]) * nvec[part * 16 + i];
      s += __shfl_xor(s, 1); s += __shfl_xor(s, 2);
      if (part == 0) qn[l_] = s;
    }
    __syncthreads();
    float decay = vecs[256];
    f32x4 a1[4], a2[4];
#pragma unroll
    for (int i = 0; i < 4; ++i) { a1[i] = (f32x4){0.f, 0.f, 0.f, 0.f}; a2[i] = (f32x4){0.f, 0.f, 0.f, 0.f}; }
#pragma unroll
    for (int ks = 0; ks < 2; ++ks) {
      bf16x8 a = ldfrag72(QCs, 16 * wid + fr, ks, fq);
#pragma unroll
      for (int nt = 0; nt < 4; ++nt) a1[nt] = mfma16(a, ldfrag72(CTs, nt * 16 + fr, ks, fq), a1[nt]);
    }
#pragma unroll
    for (int ks = 0; ks < 2; ++ks) {
      bf16x8 a = ldfrag72(Ps, 16 * wid + fr, ks, fq);
#pragma unroll
      for (int nt = 0; nt < 4; ++nt) a2[nt] = mfma16(a, ldfrag72(VTs, nt * 16 + fr, ks, fq), a2[nt]);
    }
#pragma unroll
    for (int j = 0; j < 4; ++j) {
      int l_ = 16 * wid + fq * 4 + j;
      float ai = vecs[l_], en = vecs[64 + l_], rs = vecs[128 + l_];
      float den = ai * qn[l_] + rs;
      float dn = fmaxf(fabsf(den), en);
      float inv = 1.f / dn;
      size_t row = (size_t)b * SEQ + n * 64 + l_;
      float hv[4]; float s = 0.f;
#pragma unroll
      for (int nt = 0; nt < 4; ++nt) {
        size_t idx = row * PROJ_LD + 2816 + h * 64 + nt * 16 + fr;
        float og = sigmf(orw[j][nt]);
        hv[nt] = (ai * a1[nt][j] + a2[nt][j]) * inv * og;
        s += hv[nt];
      }
      s = red16_sum(s);
      float mu = s * (1.f / 64.f);
      float q = 0.f;
#pragma unroll
      for (int nt = 0; nt < 4; ++nt) { float d = hv[nt] - mu; q += d * d; }
      q = red16_sum(q);
      float rstd = rsqrtf(q * (1.f / 64.f) + 1e-6f);
#pragma unroll
      for (int nt = 0; nt < 4; ++nt) {
        size_t idx = row * PROJ_LD + 2816 + h * 64 + nt * 16 + fr;
        proj[idx] = f2bf((hv[nt] - mu) * rstd * mn[nt]);
      }
    }
#pragma unroll
    for (int nt = 0; nt < 4; ++nt) { ct[nt][0] *= decay; ct[nt][1] *= decay; ct[nt][2] *= decay; ct[nt][3] *= decay; }
#pragma unroll
    for (int ks = 0; ks < 2; ++ks) {
      bf16x8 a = ldfrag72(VTs, 16 * wid + fr, ks, fq);
#pragma unroll
      for (int nt = 0; nt < 4; ++nt) ct[nt] = mfma16(a, ldfrag72(SKs, nt * 16 + fr, ks, fq), ct[nt]);
    }
    float nnew = 0.f;
    if (tid < 64) nnew = decay * nvec[tid] + vecs[192 + tid];
    __syncthreads();
#pragma unroll
    for (int nt = 0; nt < 4; ++nt)
#pragma unroll
      for (int j = 0; j < 4; ++j) CTs[(16 * wid + fq * 4 + j) * 72 + nt * 16 + fr] = f2bf(ct[nt][j]);
    if (tid < 64) nvec[tid] = nnew;
    if (n + 1 < 128) {
#pragma unroll
      for (int i = 0; i < 6; ++i) { int q = i * 256 + tid; int mat = q >> 9, r = (q >> 3) & 63, c = q & 7; *(u32x4*)(QCs + mat * 64 * 72 + r * 72 + c * 8) = WR[i]; }
#pragma unroll
      for (int i = 0; i < 2; ++i) { int q = i * 256 + tid; int r = q >> 3, c = q & 7; *(u32x4*)(VTs + r * 72 + c * 8) = WR[6 + i]; }
      if (tid < 80) *(f32x4*)(vecs + tid * 4) = WRV;
    }
    __syncthreads();
  };
  for (int n = 0; n < 128; n += 2) { step(n, prb, prvb, pre, prev); step(n + 1, pre, prev, prb, prvb); }
}

__device__ __forceinline__ bool moba_next(int& blk, int& kt, int own, int nown, unsigned um) {
  ++kt;
  for (;;) {
    if (blk > own) return false;
    bool isown = (blk == own);
    bool sel = isown || ((um >> blk) & 1u);
    int ntile = isown ? nown : 4;
    if (sel && kt < ntile) return true;
    ++blk; kt = 0;
  }
}
__device__ void moba_item(const Params& p, int idx, unsigned char* smem) {
  int qt = 127 - (idx >> 4), bh = idx & 15, b = bh >> 2, h = bh & 3;
  int tid = get_tid(), wid = tid >> 6, lane = tid & 63, fr = lane & 15, fq = lane >> 4;
  int t0 = qt * 64, own = t0 >> 8;
  u16* KV = (u16*)smem;
  u16* Qs = KV + 4 * 64 * 72; u16* Ps = Qs + 64 * 72;
  float* km = (float*)(Ps + 64 * 72);
  float* gate = km + 32 * 64;
  unsigned* selm = (unsigned*)(gate + 64 * 33);
  unsigned* uni = selm + 64;
  u16* proj = (u16*)(p.ws + OFF_PROJ);
  const u16* vbt = (const u16*)(p.ws + OFF_VBT) + (size_t)bh * 64 * SEQ;
  const u16* kbase = proj + (size_t)b * SEQ * PROJ_LD + 1920 + h * 64;
  const float* kmean = (const float*)(p.ws + OFF_KMEAN) + (size_t)bh * 32 * 64;
  __syncthreads();
#pragma unroll
  for (int i = 0; i < 2; ++i) { int q = i * 256 + tid; int r = q >> 3, c = q & 7; *(u32x4*)(Qs + r * 72 + c * 8) = *(const u32x4*)(proj + ((size_t)b * SEQ + t0 + r) * PROJ_LD + 2560 + h * 64 + c * 8); }
  if (tid == 0) *uni = 0u;
  {
    const float* gm = (const float*)(p.ws + OFF_GM) + ((size_t)b * SEQ + t0) * 128 + h * 32;
    for (int i = tid; i < 64 * 32; i += NT) { int q = i >> 5, nb = i & 31; if (nb < own) gate[q * 33 + nb] = gm[(size_t)q * 128 + nb]; }
  }
  __syncthreads();
  if (tid < 64) {
    unsigned m = 0u;
    for (int r = 0; r < 3; ++r) {
      float best = -INFINITY; int bi = -1;
      for (int nb = 0; nb < own; ++nb) { float gv = gate[tid * 33 + nb]; if (!((m >> nb) & 1u) && gv > best) { best = gv; bi = nb; } }
      if (bi >= 0) m |= (1u << bi);
    }
    selm[tid] = m;
    if (m) atomicOr(uni, m);
  }
  __syncthreads();
  unsigned um = *uni;
  bf16x8 qf[2];
  qf[0] = ldfrag72(Qs, 16 * wid + fr, 0, fq); qf[1] = ldfrag72(Qs, 16 * wid + fr, 1, fq);
  unsigned mysel[4]; float mrun[4], lrun[4];
#pragma unroll
  for (int j = 0; j < 4; ++j) { mysel[j] = selm[16 * wid + fq * 4 + j]; mrun[j] = -INFINITY; lrun[j] = 0.f; }
  f32x4 o[4];
#pragma unroll
  for (int i = 0; i < 4; ++i) o[i] = (f32x4){0.f, 0.f, 0.f, 0.f};
  int nown = ((t0 - own * 256) >> 6) + 1;
  int blk = 0, kt = -1;
  bool have = moba_next(blk, kt, own, nown, um);
  u32x4 pk[2], pv[2];
  {
    int key0 = blk * 256 + kt * 64;
#pragma unroll
    for (int i = 0; i < 2; ++i) {
      int q = i * 256 + tid; int r = q >> 3, c = q & 7;
      pk[i] = *(const u32x4*)(kbase + (size_t)(key0 + r) * PROJ_LD + c * 8);
      pv[i] = *(const u32x4*)(vbt + (size_t)r * SEQ + key0 + c * 8);
    }
#pragma unroll
    for (int i = 0; i < 2; ++i) {
      int q = i * 256 + tid; int r = q >> 3, c = q & 7;
      *(u32x4*)(KV + r * 72 + c * 8) = pk[i];
      *(u32x4*)(KV + 64 * 72 + r * 72 + c * 8) = pv[i];
    }
  }
  __syncthreads();
  int it = 0;
  while (have) {
    int cblk = blk, ckt = kt;
    bool hn = moba_next(blk, kt, own, nown, um);
    if (hn) {
      int key0n = blk * 256 + kt * 64;
#pragma unroll
      for (int i = 0; i < 2; ++i) {
        int q = i * 256 + tid; int r = q >> 3, c = q & 7;
        pk[i] = *(const u32x4*)(kbase + (size_t)(key0n + r) * PROJ_LD + c * 8);
        pv[i] = *(const u32x4*)(vbt + (size_t)r * SEQ + key0n + c * 8);
      }
    }
    const u16* Ks = KV + (it & 1) * 2 * 64 * 72; const u16* Vts = Ks + 64 * 72;
    bool isown = (cblk == own);
    int key0 = cblk * 256 + ckt * 64;
    f32x4 s[4];
#pragma unroll
    for (int i = 0; i < 4; ++i) s[i] = (f32x4){0.f, 0.f, 0.f, 0.f};
#pragma unroll
    for (int ks = 0; ks < 2; ++ks)
#pragma unroll
      for (int nt = 0; nt < 4; ++nt) s[nt] = mfma16(qf[ks], ldfrag72(Ks, nt * 16 + fr, ks, fq), s[nt]);
#pragma unroll
    for (int j = 0; j < 4; ++j) {
      int qpos = t0 + 16 * wid + fq * 4 + j;
      bool rowok = isown ? true : (((mysel[j] >> cblk) & 1u) != 0u);
      float mx = -INFINITY;
#pragma unroll
      for (int nt = 0; nt < 4; ++nt) {
        int key = key0 + nt * 16 + fr;
        bool ok = isown ? (key <= qpos) : rowok;
        float v = ok ? s[nt][j] * 0.125f : -INFINITY;
        s[nt][j] = v; mx = fmaxf(mx, v);
      }
      mx = red16_max(mx);
      float mnew = fmaxf(mrun[j], mx);
      float msafe = (mnew == -INFINITY) ? 0.f : mnew;
      float sc = __expf(mrun[j] - msafe);
      float ps = 0.f;
#pragma unroll
      for (int nt = 0; nt < 4; ++nt) { float pe = __expf(s[nt][j] - msafe); ps += pe; s[nt][j] = pe; }
      ps = red16_sum(ps);
      lrun[j] = lrun[j] * sc + ps; mrun[j] = mnew;
#pragma unroll
      for (int nt = 0; nt < 4; ++nt) o[nt][j] *= sc;
    }
#pragma unroll
    for (int nt = 0; nt < 4; ++nt)
#pragma unroll
      for (int j = 0; j < 4; ++j) Ps[(16 * wid + fq * 4 + j) * 72 + nt * 16 + fr] = f2bf(s[nt][j]);
    asm volatile("s_waitcnt lgkmcnt(0)" ::: "memory");
#pragma unroll
    for (int ks = 0; ks < 2; ++ks) {
      bf16x8 a = ldfrag72(Ps, 16 * wid + fr, ks, fq);
#pragma unroll
      for (int nt = 0; nt < 4; ++nt) o[nt] = mfma16(a, ldfrag72(Vts, nt * 16 + fr, ks, fq), o[nt]);
    }
    if (hn) {
      u16* Kn = KV + ((it + 1) & 1) * 2 * 64 * 72;
#pragma unroll
      for (int i = 0; i < 2; ++i) {
        int q = i * 256 + tid; int r = q >> 3, c = q & 7;
        *(u32x4*)(Kn + r * 72 + c * 8) = pk[i];
        *(u32x4*)(Kn + 64 * 72 + r * 72 + c * 8) = pv[i];
      }
    }
    __syncthreads();
    have = hn; ++it;
  }
#pragma unroll
  for (int j = 0; j < 4; ++j) {
    float inv = 1.f / lrun[j];
    size_t row = (size_t)b * SEQ + t0 + 16 * wid + fq * 4 + j;
#pragma unroll
    for (int nt = 0; nt < 4; ++nt) proj[row * PROJ_LD + 2560 + h * 64 + nt * 16 + fr] = f2bf(o[nt][j] * inv);
  }
}

__device__ __forceinline__ void grid_barrier(unsigned* bar, unsigned target) {
  asm volatile("s_waitcnt vmcnt(0) lgkmcnt(0)" ::: "memory");
  __syncthreads();
  if (threadIdx.x == 0) {
    __builtin_amdgcn_fence(__ATOMIC_RELEASE, "agent");
    asm volatile("s_waitcnt vmcnt(0)" ::: "memory");
    __hip_atomic_fetch_add(bar, 1u, __ATOMIC_RELAXED, __HIP_MEMORY_SCOPE_AGENT);
    while (__hip_atomic_load(bar, __ATOMIC_RELAXED, __HIP_MEMORY_SCOPE_AGENT) < target) __builtin_amdgcn_s_sleep(2);
    __builtin_amdgcn_fence(__ATOMIC_ACQUIRE, "agent");
    asm volatile("s_waitcnt vmcnt(0)" ::: "memory");
  }
  __syncthreads();
  asm volatile("buffer_inv sc1\n\ts_waitcnt vmcnt(0)" ::: "memory");
}

__global__ void __launch_bounds__(NT, 2) fwd_megakernel(Params p) {
  __shared__ __attribute__((aligned(16))) unsigned char smem[SMEM_BYTES];
  cg::grid_group grid = cg::this_grid();
  int* ctr = (int*)(p.ws + OFF_CTR);
  u16* wt = (u16*)(p.ws + OFF_WT);
  u16* Abuf = (u16*)(p.ws + OFF_GDNI);
  u16* hbuf = (u16*)(p.ws + OFF_PROJ);
  int ph = 0;
#define PH_BEGIN if (ph >= p.ph_lo && ph < p.ph_hi) {
#define PH_END } ++ph; if (p.coop && ph > p.ph_lo && ph < p.ph_hi) { grid_barrier(gbar, (unsigned)(ph - p.ph_lo) * gridDim.x); }
  unsigned* gbar = (unsigned*)(p.ws + OFF_CTR) + 1024;
  if (p.coop) grid.sync();
  PH_BEGIN
    for (int it = blockIdx.x; it < 576 + NCONV_ITEMS; it += gridDim.x) {
      if (it < 576) modp_item(p, it, smem); else convert_item(p, 0, it - 576, smem);
    }
  PH_END
  PH_BEGIN
    mod_finalize(p);
  PH_END
  PH_BEGIN
    ln_phase(p, false, 0, 0, true, 0, 0);
  PH_END
  for (int l0 = 0; l0 < 2; ++l0) {
    int l = l0; asm volatile("" : "+s"(l));
    EpiArgs ea;
    PH_BEGIN
      ea.xres = nullptr; ea.l = l; ea.sub = 0; ea.gs = 0.f;
      gemm_phase<EPI_SWIGLU>(p, Abuf, DM, wt + WT13_OFF(0), 1024, 44, ea, smem, -1, true);
    PH_END
    PH_BEGIN
      ea.xres = (l == 0) ? p.x : p.out; ea.l = l; ea.sub = 0; ea.gs = 0.5f;
      gemm_phase<EPI_RES>(p, hbuf, DFF, wt + WT2_OFF(0), 2816, 8, ea, smem);
    PH_END
    PH_BEGIN
      ln_phase(p, true, l, 0, true, l, 1);
    PH_END
    PH_BEGIN
      for (int it = blockIdx.x; it < 512; it += gridDim.x) u_item(p, l, it, smem);
    PH_END
    PH_BEGIN
      ea.xres = nullptr; ea.l = l; ea.sub = 1; ea.gs = 0.f;
      gemm_phase<EPI_PROJ>(p, Abuf, DM, wt + WTIN_OFF, 1024, 31, ea, smem, -1, true);
      gemm_phase<EPI_PROJ>(p, Abuf, DM, wt + WTIN_OFF, 1024, 31, ea, smem, 31);
      { float* xbz = (float*)(p.ws + OFF_XBAR);
        for (int i = blockIdx.x * NT + get_tid(); i < 128 * 1024; i += gridDim.x * NT) xbz[i] = 0.f; }
    PH_END
    PH_BEGIN
      int* c = ctr + (l * 3 + 0) * 16;
      for (;;) {
        int it = next_item(c);
        if (it >= 24 + 3072) break;
        if (it < 24) mchain_item(p, l, it, smem);
        else gdn_local_item(p, l, it - 24, smem);
      }
    PH_END
    PH_BEGIN
      int* c = ctr + (l * 3 + 1) * 16;
      if (blockIdx.x < 24) { __builtin_amdgcn_s_setprio(3); gdn_scan_item(p, l, blockIdx.x, smem); __builtin_amdgcn_s_setprio(0); }
      if (!(gridDim.x == 512 && blockIdx.x >= 256 && blockIdx.x < 280))
      for (;;) {
        int it = next_item(c) + 24;
        if (it >= 24 + 3072 + 1024) break;
        if (it < 3096) mlstm_local_item(p, l, it - 24, smem);
        else moba_item(p, it - 3096, smem);
      }
    PH_END
    PH_BEGIN
      int* c = ctr + (l * 3 + 2) * 16;
      if (blockIdx.x < 24) { __builtin_amdgcn_s_setprio(3); mlstm_scan_item(p, l, blockIdx.x, smem); __builtin_amdgcn_s_setprio(0); }
      if (!(gridDim.x == 512 && blockIdx.x >= 256 && blockIdx.x < 280))
      for (;;) {
        int it = next_item(c) + 24;
        if (it >= 24 + 1024) break;
        moba_item(p, 1024 + it - 24, smem);
      }
    PH_END
    PH_BEGIN
      ea.xres = p.out; ea.l = l; ea.sub = 1; ea.gs = 1.0f;
      gemm_phase<EPI_RES>(p, hbuf + 2176, PROJ_LD, wt + WTOUT_OFF, 1024, 8, ea, smem);
    PH_END
    PH_BEGIN
      ln_phase(p, true, l, 1, true, l, 2);
    PH_END
    PH_BEGIN
      ea.xres = nullptr; ea.l = l; ea.sub = 2; ea.gs = 0.f;
      gemm_phase<EPI_SWIGLU>(p, Abuf, DM, wt + WT13_OFF(1), 1024, 44, ea, smem, -1, true);
    PH_END
    PH_BEGIN
      ea.xres = p.out; ea.l = l; ea.sub = 2; ea.gs = 0.5f;
      gemm_phase<EPI_RES>(p, hbuf, DFF, wt + WT2_OFF(1), 2816, 8, ea, smem);
    PH_END
    PH_BEGIN
      ln_phase(p, true, l, 2, l == 0, 1, 0);
      if (l == 0) for (int it = blockIdx.x; it < NCONV_ITEMS; it += gridDim.x) convert_item(p, 1, it, smem);
    PH_END
  }
}

#define N_PHASES 29

extern "C" void kernel_launch(void* const* d_in, const int* in_sizes, int n_in, void* d_out, int out_size,
                              void* d_ws, size_t ws_size, hipStream_t stream) {
  static int grid_blocks = 0;
  if (!grid_blocks) {
    int dev = 0, cus = 0, per_cu = 0;
    hipGetDevice(&dev);
    hipDeviceGetAttribute(&cus, hipDeviceAttributeMultiprocessorCount, dev);
    hipOccupancyMaxActiveBlocksPerMultiprocessor(&per_cu, fwd_megakernel, NT, 0);
    if (per_cu > 2) per_cu = 2;
    if (per_cu < 1) per_cu = 1;
    grid_blocks = cus * per_cu;
  }
  if (ws_size < WS_NEEDED) { fprintf(stderr, "workspace too small: %zu\n", ws_size); return; }
  Params p{};
  const float** f = (const float**)d_in;
  p.x = f[0]; p.c = f[1]; p.ada_w = f[2]; p.ada_b = f[3]; p.w13 = f[4]; p.w2 = f[5]; p.w_in = f[6]; p.w_out = f[7];
  p.gdn_conv = f[8]; p.gdn_a_log = f[9]; p.gdn_dt_bias = f[10]; p.gdn_norm = f[11]; p.mlstm_conv = f[12];
  p.mlstm_i_bias = f[13]; p.mlstm_f_bias = f[14]; p.mlstm_norm = f[15]; p.ln_g = f[16]; p.ln_b = f[17];
  p.out = (float*)d_out; p.ws = (unsigned char*)d_ws;
  p.ph_lo = 0; p.ph_hi = N_PHASES; p.coop = 1; p.pad = 0;
  hipMemsetAsync((unsigned char*)d_ws + OFF_CTR, 0, 128 * 1024 + 512 * 1024, stream);
  void* args[] = {&p};
  hipError_t e = hipLaunchCooperativeKernel((void*)fwd_megakernel, dim3(grid_blocks), dim3(NT), args, 0, stream);
  if (e != hipSuccess) fprintf(stderr, "cooperative launch failed: %s (grid %d)\n", hipGetErrorString(e), grid_blocks);
}
```

```cpp
#include <hip/hip_runtime.h>
#include <hip/hip_cooperative_groups.h>
#include <cstdio>
namespace cg = cooperative_groups;

typedef unsigned short u16;
using bf16x8 = __attribute__((ext_vector_type(8))) short;
using f32x4  = __attribute__((ext_vector_type(4))) float;
using u32x4  = __attribute__((ext_vector_type(4))) unsigned;

#define NTOK 32768
#define SEQ 8192
#define DM 1024
#define DFF 2816
#define PROJ_LD 3200
#define NT 256
#define SMEM_BYTES 73728
#define ALPHA_F 1.4142135623730951f

#define MiB (1024ull*1024ull)
#define OFF_PROJ   (0ull)
#define OFF_GDNI   (200ull*MiB)
#define OFF_MLI    (320ull*MiB)
#define OFF_WT     (396ull*MiB)
#define OFF_VCT    (439ull*MiB)
#define OFF_VBT    (463ull*MiB)
#define OFF_GATES  (479ull*MiB)
#define OFF_MODP   (482ull*MiB)
#define OFF_MOD    (484ull*MiB + 512*1024)
#define OFF_KMEAN  (485ull*MiB)
#define OFF_MCH    (485ull*MiB + 256*1024)
#define OFF_GL     (485ull*MiB + 320*1024)
#define OFF_CTR    (485ull*MiB + 384*1024)
#define OFF_XBAR   (485ull*MiB + 512*1024)
#define OFF_UH     (486ull*MiB)
#define OFF_UL     (487ull*MiB)
#define OFF_GM     (488ull*MiB)
#define OFF_ALO    OFF_MLI
#define WS_NEEDED  (504ull*MiB)

#define GDNI_STRIDE 20480
#define MLI_STRIDE  25856

#define WT13_OFF(f) ((size_t)(f)*5632*1024)
#define WT2_OFF(f)  ((size_t)2*5632*1024 + (size_t)(f)*1024*2816)
#define WTIN_OFF    ((size_t)2*5632*1024 + (size_t)2*1024*2816)
#define WTOUT_OFF   (WTIN_OFF + (size_t)3968*1024)

struct Params {
  const float *x, *c, *ada_w, *ada_b, *w13, *w2, *w_in, *w_out, *gdn_conv, *gdn_a_log, *gdn_dt_bias, *gdn_norm,
              *mlstm_conv, *mlstm_i_bias, *mlstm_f_bias, *mlstm_norm, *ln_g, *ln_b;
  float* out;
  unsigned char* ws;
  int ph_lo, ph_hi, coop, pad;
};

__device__ __forceinline__ int get_tid() { int t = threadIdx.x; asm volatile("" : "+v"(t)); return t; }
__device__ __forceinline__ u16 f2bf(float f) {
  f = fminf(fmaxf(f, -65000.f), 65000.f);
  _Float16 h = (_Float16)f;
  return __builtin_bit_cast(u16, h);
}
__device__ __forceinline__ float bf2f(u16 h) { return (float)__builtin_bit_cast(_Float16, h); }
__device__ __forceinline__ float siluf(float x) { return x / (1.f + __expf(-x)); }
__device__ __forceinline__ float sigmf(float x) { return 1.f / (1.f + __expf(-x)); }
__device__ __forceinline__ float softplusf(float x) { return x > 20.f ? x : log1pf(expf(x)); }
__device__ __forceinline__ float logsigf(float x) { return fminf(x, 0.f) - log1pf(expf(-fabsf(x))); }
__device__ __forceinline__ bf16x8 ldfrag72(const u16* base, int row, int ks, int fq) {
  return *(const bf16x8*)(base + row * 72 + ks * 32 + fq * 8);
}
using f16x8 = __attribute__((ext_vector_type(8))) _Float16;
__device__ __forceinline__ f32x4 mfma16(bf16x8 a, bf16x8 b, f32x4 c) {
  return __builtin_amdgcn_mfma_f32_16x16x32_f16(__builtin_bit_cast(f16x8, a), __builtin_bit_cast(f16x8, b), c, 0, 0, 0);
}
template <int CTRL> __device__ __forceinline__ float dpp_mov(float v) {
  return __builtin_bit_cast(float, __builtin_amdgcn_update_dpp(0, __builtin_bit_cast(int, v), CTRL, 0xF, 0xF, true));
}
__device__ __forceinline__ float red16_sum(float v) {
  v += dpp_mov<0xB1>(v); v += dpp_mov<0x4E>(v); v += dpp_mov<0x124>(v); v += dpp_mov<0x128>(v); return v;
}
__device__ __forceinline__ float red16_max(float v) {
  v = fmaxf(v, dpp_mov<0xB1>(v)); v = fmaxf(v, dpp_mov<0x4E>(v)); v = fmaxf(v, dpp_mov<0x124>(v)); v = fmaxf(v, dpp_mov<0x128>(v)); return v;
}
__device__ __forceinline__ float mod_get(const Params& p, int l, int b, int j) {
  return ((const float*)(p.ws + OFF_MOD))[(size_t)(l * 4 + b) * 9216 + j];
}
__device__ void mod_finalize(const Params& p) {
  const float* mp = (const float*)(p.ws + OFF_MODP);
  float* mo = (float*)(p.ws + OFF_MOD);
  for (int i = blockIdx.x * NT + get_tid(); i < 2 * 4 * 9216; i += gridDim.x * NT) {
    int j = i % 9216, lb = i / 9216, l = lb >> 2, b = lb & 3;
    float s = p.ada_b[l * 9216 + j];
    for (int ks = 0; ks < 8; ++ks) s += mp[(size_t)((l * 8 + ks) * 4 + b) * 9216 + j];
    mo[i] = s;
  }
}
__device__ __forceinline__ float ld_agent(const float* p) { return __hip_atomic_load(p, __ATOMIC_RELAXED, __HIP_MEMORY_SCOPE_AGENT); }
__device__ __forceinline__ int next_item(int* ctr) {
  __shared__ int s_item;
  __syncthreads();
  if (get_tid() == 0) s_item = atomicAdd(ctr, 1);
  __syncthreads();
  return s_item;
}

__device__ void modp_item(const Params& p, int item, unsigned char* smem) {
  int ks = item & 7, jc = (item >> 3) % 36, l = item / 288;
  float* sc = (float*)smem;
  int tid = get_tid();
  __syncthreads();
  for (int i = tid; i < 512; i += NT) { int b = i >> 7, k = i & 127; float cv = p.c[b * DM + ks * 128 + k]; sc[i] = cv / (1.f + expf(-cv)); }
  __syncthreads();
  int j = jc * 256 + tid;
  const float* w = p.ada_w + ((size_t)l * DM + ks * 128) * 9216 + j;
  float a0 = 0, a1 = 0, a2 = 0, a3 = 0;
#pragma unroll 8
  for (int k = 0; k < 128; ++k) { float wv = w[(size_t)k * 9216]; a0 += sc[k] * wv; a1 += sc[128 + k] * wv; a2 += sc[256 + k] * wv; a3 += sc[384 + k] * wv; }
  float* mp = (float*)(p.ws + OFF_MODP) + (size_t)((l * 8 + ks) * 4) * 9216 + j;
  mp[0] = a0; mp[9216] = a1; mp[2 * 9216] = a2; mp[3 * 9216] = a3;
}

__device__ __forceinline__ int win_map(int r) {
  if (r < 1152) return r;
  if (r < 2304) return 2316 + (r - 1152);
  if (r < 2560) return 1804 + (r - 2304);
  if (r < 2816) return 2060 + (r - 2560);
  if (r < 3200) return 1164 + (r - 2816);
  if (r < 3456) return 1548 + (r - 3200);
  if (r < 3840) return 3480 + (r - 3456);
  if (r < 3852) return 1152 + (r - 3840);
  if (r < 3864) return 3468 + (r - 3852);
  return -1;
}
#define NCONV_ITEMS 5472
__device__ void convert_item(const Params& p, int l, int idx, unsigned char* smem) {
  float* t = (float*)smem;
  int tid = get_tid();
  const float* src; u16* dst; int Nsrc, K, n0, k0, mode;
  u16* wt = (u16*)(p.ws + OFF_WT);
  if (idx < 2816) { int f = idx / 1408, r = idx % 1408; n0 = (r / 16) * 64; k0 = (r % 16) * 64; src = p.w13 + (size_t)(l * 2 + f) * 1024 * 5632; Nsrc = 5632; K = 1024; dst = wt + WT13_OFF(f); mode = 1; }
  else if (idx < 4224) { int q = idx - 2816; int f = q / 704, r = q % 704; n0 = (r / 44) * 64; k0 = (r % 44) * 64; src = p.w2 + (size_t)(l * 2 + f) * 2816 * 1024; Nsrc = 1024; K = 2816; dst = wt + WT2_OFF(f); mode = 0; }
  else if (idx < 5216) { int r = idx - 4224; n0 = (r / 16) * 64; k0 = (r % 16) * 64; src = p.w_in + (size_t)l * 1024 * 3864; Nsrc = 3864; K = 1024; dst = wt + WTIN_OFF; mode = 2; }
  else { int r = idx - 5216; n0 = (r / 16) * 64; k0 = (r % 16) * 64; src = p.w_out + (size_t)l * 1024 * 1024; Nsrc = 1024; K = 1024; dst = wt + WTOUT_OFF; mode = 0; }
  __syncthreads();
  {
    int c = tid & 63, kr = tid >> 6;
    int nd = n0 + c, ns;
    if (mode == 0) ns = nd;
    else if (mode == 1) { int grp = nd >> 6, w = nd & 63; ns = grp * 32 + (w & 31) + ((w & 32) ? 2816 : 0); }
    else ns = win_map(nd);
#pragma unroll 4
    for (int it = 0; it < 16; ++it) {
      int kk = it * 4 + kr;
      float v = (ns >= 0) ? src[(size_t)(k0 + kk) * Nsrc + ns] : 0.f;
      t[kk * 65 + c] = v;
    }
  }
  __syncthreads();
  {
    int n = tid >> 2, kq = tid & 3;
    unsigned pk[8];
#pragma unroll
    for (int i = 0; i < 8; ++i) {
      u16 lo = f2bf(t[(kq * 16 + 2 * i) * 65 + n]);
      u16 hi = f2bf(t[(kq * 16 + 2 * i + 1) * 65 + n]);
      pk[i] = (unsigned)lo | ((unsigned)hi << 16);
    }
    uint4* o = (uint4*)(dst + (size_t)(n0 + n) * K + k0 + kq * 16);
    o[0] = make_uint4(pk[0], pk[1], pk[2], pk[3]);
    o[1] = make_uint4(pk[4], pk[5], pk[6], pk[7]);
  }
}

__device__ void ln_phase(const Params& p, bool do_ln, int lg, int sg, bool do_a, int l2, int sub2) {
  int tid = get_tid(), lane = tid & 63;
  int gw = blockIdx.x * 4 + (tid >> 6), GW = gridDim.x * 4;
  int R = (NTOK + GW - 1) / GW;
  int r0 = gw * R, r1 = min(r0 + R, NTOK);
  const float* src = do_ln ? p.out : p.x;
  u16* A = (u16*)(p.ws + OFF_GDNI);
  float g[16], bb[16], sh[16], sc[16];
  if (do_ln) {
#pragma unroll
    for (int i = 0; i < 4; ++i)
#pragma unroll
      for (int e = 0; e < 4; ++e) { int col = i * 256 + lane * 4 + e; g[i * 4 + e] = p.ln_g[(lg * 3 + sg) * DM + col]; bb[i * 4 + e] = p.ln_b[(lg * 3 + sg) * DM + col]; }
  }
  int curb = -1;
  float xs[16];
#pragma unroll
  for (int i = 0; i < 16; ++i) xs[i] = 0.f;
  int xblk = -1;
  for (int r = r0; r < r1; ++r) {
    int b = r / SEQ;
    if (do_a && b != curb) {
      curb = b;
#pragma unroll
      for (int i = 0; i < 4; ++i)
#pragma unroll
        for (int e = 0; e < 4; ++e) { int col = i * 256 + lane * 4 + e; sh[i * 4 + e] = mod_get(p, l2, b, sub2 * 3072 + col); sc[i * 4 + e] = 1.f + mod_get(p, l2, b, sub2 * 3072 + 1024 + col); }
    }
    float v[16];
#pragma unroll
    for (int i = 0; i < 4; ++i) { float4 t = *(const float4*)(src + (size_t)r * DM + i * 256 + lane * 4); v[i * 4] = t.x; v[i * 4 + 1] = t.y; v[i * 4 + 2] = t.z; v[i * 4 + 3] = t.w; }
    if (do_ln) {
      float s = 0;
#pragma unroll
      for (int i = 0; i < 16; ++i) s += v[i];
#pragma unroll
      for (int o = 1; o < 64; o <<= 1) s += __shfl_xor(s, o);
      float mu = s * (1.f / 1024.f);
      float q = 0;
#pragma unroll
      for (int i = 0; i < 16; ++i) { float d = v[i] - mu; q += d * d; }
#pragma unroll
      for (int o = 1; o < 64; o <<= 1) q += __shfl_xor(q, o);
      float rs = rsqrtf(q * (1.f / 1024.f) + 1e-5f);
#pragma unroll
      for (int i = 0; i < 16; ++i) v[i] = (v[i] - mu) * rs * g[i] + bb[i];
#pragma unroll
      for (int i = 0; i < 4; ++i) *(float4*)(p.out + (size_t)r * DM + i * 256 + lane * 4) = make_float4(v[i * 4], v[i * 4 + 1], v[i * 4 + 2], v[i * 4 + 3]);
    }
    if (do_a && sub2 == 1) {
      u16* Alo = (u16*)(p.ws + OFF_ALO);
      int blk = r >> 8;
      if (blk != xblk) {
        if (xblk >= 0) {
          float* xb = (float*)(p.ws + OFF_XBAR) + (size_t)xblk * DM;
#pragma unroll
          for (int i = 0; i < 4; ++i)
#pragma unroll
            for (int e = 0; e < 4; ++e) { atomicAdd(xb + i * 256 + lane * 4 + e, xs[i * 4 + e]); xs[i * 4 + e] = 0.f; }
        }
        xblk = blk;
      }
#pragma unroll
      for (int i = 0; i < 4; ++i) {
        u16 lo[4];
#pragma unroll
        for (int e = 0; e < 4; ++e) {
          float xm = v[i * 4 + e] * sc[i * 4 + e] + sh[i * 4 + e];
          xs[i * 4 + e] += xm;
          lo[e] = f2bf(xm - bf2f(f2bf(xm)));
        }
        *(uint2*)(Alo + (size_t)r * DM + i * 256 + lane * 4) = make_uint2((unsigned)lo[0] | ((unsigned)lo[1] << 16), (unsigned)lo[2] | ((unsigned)lo[3] << 16));
      }
    }
    if (do_a) {
#pragma unroll
      for (int i = 0; i < 4; ++i) {
        u16 a0 = f2bf(v[i * 4] * sc[i * 4] + sh[i * 4]), a1 = f2bf(v[i * 4 + 1] * sc[i * 4 + 1] + sh[i * 4 + 1]);
        u16 a2 = f2bf(v[i * 4 + 2] * sc[i * 4 + 2] + sh[i * 4 + 2]), a3 = f2bf(v[i * 4 + 3] * sc[i * 4 + 3] + sh[i * 4 + 3]);
        *(uint2*)(A + (size_t)r * DM + i * 256 + lane * 4) = make_uint2((unsigned)a0 | ((unsigned)a1 << 16), (unsigned)a2 | ((unsigned)a3 << 16));
      }
    }
  }
  if (xblk >= 0) {
    float* xb = (float*)(p.ws + OFF_XBAR) + (size_t)xblk * DM;
#pragma unroll
    for (int i = 0; i < 4; ++i)
#pragma unroll
      for (int e = 0; e < 4; ++e) atomicAdd(xb + i * 256 + lane * 4 + e, xs[i * 4 + e]);
  }
}

__device__ void u_item(const Params& p, int l, int item, unsigned char* smem) {
  int h = item & 3, nb = (item >> 2) & 31, b = item >> 7, tid = get_tid();
  float* xb = (float*)smem; float* red = xb + 1024; float* kb = red + 256;
  const float* XB = (const float*)(p.ws + OFF_XBAR) + (size_t)(b * 32 + nb) * DM;
  const float* W = p.w_in + (size_t)l * 1024 * 3864;
  __syncthreads();
  for (int i = tid; i < 1024; i += NT) xb[i] = XB[i] * (1.f / 256.f);
  __syncthreads();
  {
    int j = tid & 63, kq = tid >> 6;
    const float* wk = W + (size_t)(kq * 256) * 3864 + 1804 + h * 64 + j;
    float s = 0.f;
#pragma unroll 8
    for (int k = 0; k < 256; ++k) s += xb[kq * 256 + k] * wk[(size_t)k * 3864];
    red[kq * 64 + j] = s;
  }
  __syncthreads();
  if (tid < 64) kb[tid] = red[tid] + red[64 + tid] + red[128 + tid] + red[192 + tid];
  __syncthreads();
  u16* UH = (u16*)(p.ws + OFF_UH) + ((size_t)b * 128 + h * 32 + nb) * 1024;
  u16* UL = (u16*)(p.ws + OFF_UL) + ((size_t)b * 128 + h * 32 + nb) * 1024;
  for (int i = 0; i < 4; ++i) {
    int k = i * 256 + tid;
    const float* wq = W + (size_t)k * 3864 + 1548 + h * 64;
    float s = 0.f;
#pragma unroll
    for (int j = 0; j < 64; j += 4) { float4 wv = *(const float4*)(wq + j); s += wv.x * kb[j] + wv.y * kb[j + 1] + wv.z * kb[j + 2] + wv.w * kb[j + 3]; }
    u16 hi = f2bf(s);
    UH[k] = hi; UL[k] = f2bf(s - bf2f(hi));
  }
}

enum { EPI_SWIGLU = 0, EPI_RES = 1, EPI_PROJ = 2 };
struct EpiArgs { const float* xres; int l, sub; float gs; };

__device__ __forceinline__ void gemm_stage(const u16* A, int lda, const u16* Bt, int K, int brow, int bcol, int kt, unsigned char* buf) {
  int tid = get_tid();
#pragma unroll
  for (int i = 0; i < 4; ++i) {
    int pidx = i * 256 + tid; int r = pidx >> 3, cp = pidx & 7; int cl = cp ^ ((r >> 1) & 7);
    __builtin_amdgcn_global_load_lds((const unsigned*)(A + (size_t)(brow + r) * lda + kt * 64 + cl * 8), (unsigned*)(buf + pidx * 16), 16, 0, 0);
  }
#pragma unroll
  for (int i = 0; i < 4; ++i) {
    int pidx = i * 256 + tid; int r = pidx >> 3, cp = pidx & 7; int cl = cp ^ ((r >> 1) & 7);
    __builtin_amdgcn_global_load_lds((const unsigned*)(Bt + (size_t)(bcol + r) * K + kt * 64 + cl * 8), (unsigned*)(buf + 16384 + pidx * 16), 16, 0, 0);
  }
}
__device__ __forceinline__ bf16x8 ldfrag_sw(const unsigned char* buf, int row, int cl) {
  return *(const bf16x8*)(buf + row * 128 + ((cl ^ ((row >> 1) & 7)) << 4));
}

template <int MODE>
__device__ void gemm_phase(const Params& p, const u16* A, int lda, const u16* Bt, int K, int ntn, EpiArgs ea, unsigned char* smem, int nt_fixed = -1, bool xcd_patch = false) {
  int tid = get_tid(), wid = tid >> 6, lane = tid & 63, wr = wid >> 1, wc = wid & 1, fr = lane & 15, fq = lane >> 4;
  int ntiles = (nt_fixed >= 0) ? 256 : 256 * ntn, nk = K / 64;
  int tstart = (nt_fixed >= 0) ? (int)((blockIdx.x + gridDim.x - (256 % gridDim.x)) % gridDim.x) : (int)blockIdx.x;
  bool patch = xcd_patch && nt_fixed < 0 && (gridDim.x & 7) == 0;
  int px = blockIdx.x & 7, pn0 = (ntn * (px & 3)) >> 2, png = ((ntn * ((px & 3) + 1)) >> 2) - pn0;
  int tstep = gridDim.x;
  if (patch) { tstart = blockIdx.x >> 3; ntiles = 128 * png; tstep = gridDim.x >> 3; }
  for (int t = tstart; t < ntiles; t += tstep) {
    int g = t / (8 * ntn), r = t % (8 * ntn);
    int mt = g * 8 + (r & 7), nt = r >> 3;
    if (nt_fixed >= 0) { mt = t; nt = nt_fixed; }
    if (patch) { mt = (px >> 2) * 128 + t / png; nt = pn0 + t % png; }
    int brow = mt * 128, bcol = nt * 128;
    f32x4 acc[4][4];
#pragma unroll
    for (int m = 0; m < 4; ++m)
#pragma unroll
      for (int n = 0; n < 4; ++n) acc[m][n] = (f32x4){0.f, 0.f, 0.f, 0.f};
    int b = brow / SEQ;
    const u16* B0 = Bt; const u16* B2 = Bt; const u16* A1 = A; int bc = bcol, npass = 1;
    if (MODE == EPI_PROJ && nt == 31) {
      B0 = (const u16*)(p.ws + OFF_UH) + (size_t)b * 128 * 1024; B2 = (const u16*)(p.ws + OFF_UL) + (size_t)b * 128 * 1024;
      A1 = (const u16*)(p.ws + OFF_ALO); bc = 0; npass = 3;
    }
    int nkt = nk * npass;
    __syncthreads();
    gemm_stage(A, lda, B0, K, brow, bc, 0, smem);
    for (int kt = 0; kt < nkt; ++kt) {
      asm volatile("s_waitcnt vmcnt(0)" ::: "memory");
      __syncthreads();
      unsigned char* cur = smem + (kt & 1) * 32768;
      if (kt + 1 < nkt) {
        int ps = (kt + 1) / nk, kk = (kt + 1) - ps * nk;
        gemm_stage(ps == 1 ? A1 : A, lda, ps == 2 ? B2 : B0, K, brow, bc, kk, smem + ((kt + 1) & 1) * 32768);
      }
#pragma unroll
      for (int ks = 0; ks < 2; ++ks) {
        bf16x8 af[4], bfr[4];
#pragma unroll
        for (int m = 0; m < 4; ++m) af[m] = ldfrag_sw(cur, wr * 64 + m * 16 + fr, ks * 4 + fq);
#pragma unroll
        for (int n = 0; n < 4; ++n) bfr[n] = ldfrag_sw(cur + 16384, wc * 64 + n * 16 + fr, ks * 4 + fq);
#pragma unroll
        for (int m = 0; m < 4; ++m)
#pragma unroll
          for (int n = 0; n < 4; ++n) acc[m][n] = mfma16(af[m], bfr[n], acc[m][n]);
      }
    }
    if (MODE == EPI_SWIGLU) {
      u16* hbuf = (u16*)(p.ws + OFF_PROJ);
#pragma unroll
      for (int m = 0; m < 4; ++m)
#pragma unroll
        for (int n = 0; n < 2; ++n) {
          int hid = (nt * 2 + wc) * 32 + n * 16 + fr;
#pragma unroll
          for (int j = 0; j < 4; ++j) {
            int row = brow + wr * 64 + m * 16 + fq * 4 + j;
            float a = acc[m][n][j], bv = acc[m][n + 2][j];
            hbuf[(size_t)row * DFF + hid] = f2bf(siluf(a) * bv);
          }
        }
    } else if (MODE == EPI_RES) {
#pragma unroll
      for (int n = 0; n < 4; ++n) {
        int col = bcol + wc * 64 + n * 16 + fr;
        float gate = ea.gs * (1.f + mod_get(p, ea.l, b, ea.sub * 3072 + 2048 + col));
#pragma unroll
        for (int m = 0; m < 4; ++m)
#pragma unroll
          for (int j = 0; j < 4; ++j) {
            int row = brow + wr * 64 + m * 16 + fq * 4 + j;
            size_t idx = (size_t)row * DM + col;
            p.out[idx] = ALPHA_F * ea.xres[idx] + gate * acc[m][n][j];
          }
      }
    } else {
      u16* proj = (u16*)(p.ws + OFF_PROJ);
      if (nt == 31) {
        float* gm = (float*)(p.ws + OFF_GM);
#pragma unroll
        for (int n = 0; n < 4; ++n) {
          int gc = wc * 64 + n * 16 + fr;
#pragma unroll
          for (int m = 0; m < 4; ++m)
#pragma unroll
            for (int j = 0; j < 4; ++j) { int row = brow + wr * 64 + m * 16 + fq * 4 + j; gm[(size_t)row * 128 + gc] = acc[m][n][j]; }
        }
      } else if (nt == 30) {
        float* gates = (float*)(p.ws + OFF_GATES);
#pragma unroll
        for (int n = 0; n < 4; ++n) {
          int gc = wc * 64 + n * 16 + fr;
          if (gc < 24) {
#pragma unroll
            for (int m = 0; m < 4; ++m)
#pragma unroll
              for (int j = 0; j < 4; ++j) { int row = brow + wr * 64 + m * 16 + fq * 4 + j; gates[(size_t)row * 24 + gc] = acc[m][n][j]; }
          }
        }
      } else if ((nt >= 15 && nt <= 17) || nt == 20 || nt == 21) {
        bool isc = nt < 18;
        u16* vt = (u16*)(p.ws + (isc ? OFF_VCT : OFF_VBT));
        int H = isc ? 6 : 4, cb = isc ? 1920 : 2560;
#pragma unroll
        for (int n = 0; n < 4; ++n) {
          int cc = bcol + wc * 64 + n * 16 + fr - cb; int head = cc >> 6, e = cc & 63;
#pragma unroll
          for (int m = 0; m < 4; ++m) {
            int tt = (brow - b * SEQ) + wr * 64 + m * 16 + fq * 4;
            u16 v0 = f2bf(acc[m][n][0]), v1 = f2bf(acc[m][n][1]), v2 = f2bf(acc[m][n][2]), v3 = f2bf(acc[m][n][3]);
            *(uint2*)(vt + ((size_t)(b * H + head) * 64 + e) * SEQ + tt) = make_uint2((unsigned)v0 | ((unsigned)v1 << 16), (unsigned)v2 | ((unsigned)v3 << 16));
          }
        }
      } else {
        int shift = nt < 15 ? 0 : (nt < 20 ? 384 : 640);
#pragma unroll
        for (int n = 0; n < 4; ++n) {
          int pc = bcol + wc * 64 + n * 16 + fr - shift;
#pragma unroll
          for (int m = 0; m < 4; ++m)
#pragma unroll
            for (int j = 0; j < 4; ++j) { int row = brow + wr * 64 + m * 16 + fq * 4 + j; proj[(size_t)row * PROJ_LD + pc] = f2bf(acc[m][n][j]); }
        }
      }
    }
  }
}

__device__ void mchain_item(const Params& p, int l, int bh, unsigned char* smem) {
  int b = bh / 6, h = bh % 6, tid = get_tid();
  float* bLs = (float*)smem; float* mws = bLs + 128;
  const float* gates = (const float*)(p.ws + OFF_GATES);
  __syncthreads();
  if (tid < 128) {
    float ib = p.mlstm_i_bias[l * 6 + h], fb = p.mlstm_f_bias[l * 6 + h];
    float bc = 0.f, mx = -INFINITY;
    size_t row = (size_t)b * SEQ + tid * 64;
#pragma unroll 8
    for (int s = 0; s < 64; ++s) {
      float ip = gates[(row + s) * 24 + 12 + h] + ib;
      float lf = logsigf(gates[(row + s) * 24 + 18 + h] + fb);
      bc += lf; mx = fmaxf(mx, ip - bc);
    }
    bLs[tid] = bc; mws[tid] = bc + mx;
  }
  __syncthreads();
  if (tid == 0) {
    float* mch = (float*)(p.ws + OFF_MCH) + bh * 129;
    float m = 0.f;
    for (int n = 0; n < 128; ++n) { __hip_atomic_store(&mch[n], m, __ATOMIC_RELAXED, __HIP_MEMORY_SCOPE_AGENT); m = fmaxf(bLs[n] + m, mws[n]); }
    __hip_atomic_store(&mch[128], m, __ATOMIC_RELAXED, __HIP_MEMORY_SCOPE_AGENT);
    __builtin_amdgcn_fence(__ATOMIC_RELEASE, "agent");
    asm volatile("s_waitcnt vmcnt(0)" ::: "memory");
    __hip_atomic_store((int*)(p.ws + OFF_CTR) + 512 + l * 32 + bh, 1, __ATOMIC_RELAXED, __HIP_MEMORY_SCOPE_AGENT);
  }
}

__device__ void kmean_item(const Params& p, int item, unsigned char* smem) {
  int nb = item & 31, bh = item >> 5, b = bh >> 2, h = bh & 3, tid = get_tid();
  float* red = (float*)smem;
  const u16* proj = (const u16*)(p.ws + OFF_PROJ);
  int d = tid & 63, part = tid >> 6;
  float s = 0.f;
  for (int k = 0; k < 64; ++k) s += bf2f(proj[((size_t)b * SEQ + nb * 256 + part * 64 + k) * PROJ_LD + 1920 + h * 64 + d]);
  __syncthreads();
  red[tid] = s;
  __syncthreads();
  if (tid < 64) ((float*)(p.ws + OFF_KMEAN))[(size_t)item * 64 + tid] = (red[tid] + red[64 + tid] + red[128 + tid] + red[192 + tid]) * (1.f / 256.f);
}

__device__ __forceinline__ void conv_silu_tile(const u16* proj, int b, int t0, int pcol, const float* cw, int cwld, int ccol, float* dst, float post) {
  int tid = get_tid(), d = tid & 63, rg = tid >> 6;
  float w0 = cw[ccol + d], w1 = cw[cwld + ccol + d], w2 = cw[2 * cwld + ccol + d], w3 = cw[3 * cwld + ccol + d];
  int tl0 = t0 + rg * 16;
  const u16* base = proj + (size_t)b * SEQ * PROJ_LD + pcol + d;
  float xm3 = (tl0 - 3 >= 0) ? bf2f(base[(size_t)(tl0 - 3) * PROJ_LD]) : 0.f;
  float xm2 = (tl0 - 2 >= 0) ? bf2f(base[(size_t)(tl0 - 2) * PROJ_LD]) : 0.f;
  float xm1 = (tl0 - 1 >= 0) ? bf2f(base[(size_t)(tl0 - 1) * PROJ_LD]) : 0.f;
  float xr[16];
#pragma unroll
  for (int i = 0; i < 16; ++i) xr[i] = bf2f(base[(size_t)(tl0 + i) * PROJ_LD]);
#pragma unroll
  for (int i = 0; i < 16; ++i) {
    float x0 = xr[i];
    float y = w0 * xm3 + w1 * xm2 + w2 * xm1 + w3 * x0;
    dst[(rg * 16 + i) * 65 + d] = siluf(y) * post;
    xm3 = xm2; xm2 = xm1; xm1 = x0;
  }
}

__device__ void gdn_local_item(const Params& p, int l, int item, unsigned char* smem) {
  int n = item & 127, bh = item >> 7, b = bh / 6, h = bh % 6, tid = get_tid();
  float* qs = (float*)smem; float* ks = qs + 64 * 65; float* vs = ks + 64 * 65; float* As = vs + 64 * 65;
  float* Gs = As + 64 * 64; float* betas = Gs + 64; float* eGs = betas + 64;
  const u16* proj = (const u16*)(p.ws + OFF_PROJ);
  const float* gates = (const float*)(p.ws + OFF_GATES);
  u16* outb = (u16*)(p.ws + OFF_GDNI) + (size_t)item * GDNI_STRIDE;
  u16 *w_o = outb, *u_o = outb + 4096, *at_o = outb + 8192, *qd_o = outb + 12288, *kd_o = outb + 16384;
  int t0 = n * 64;
  __syncthreads();
  const float* cw = p.gdn_conv + (size_t)l * 4 * 1152;
  conv_silu_tile(proj, b, t0, h * 64, cw, 1152, h * 64, qs, 1.f);
  conv_silu_tile(proj, b, t0, 384 + h * 64, cw, 1152, 384 + h * 64, ks, 1.f);
  conv_silu_tile(proj, b, t0, 768 + h * 64, cw, 1152, 768 + h * 64, vs, 1.f);
  if (tid < 64) {
    size_t row = (size_t)b * SEQ + t0 + tid;
    float a = ld_agent(&gates[row * 24 + h]), br = ld_agent(&gates[row * 24 + 6 + h]);
    float g = -expf(p.gdn_a_log[l * 6 + h]) * softplusf(a + p.gdn_dt_bias[l * 6 + h]);
    float beta = 1.f / (1.f + expf(-br));
    float G = g;
#pragma unroll
    for (int o = 1; o < 64; o <<= 1) { float t = __shfl_up(G, o); if (tid >= o) G += t; }
    Gs[tid] = G; betas[tid] = beta; eGs[tid] = expf(G);
  }
  __syncthreads();
  {
    int row = tid >> 2, part = tid & 3;
    float sq = 0.f, sk = 0.f;
#pragma unroll
    for (int i = 0; i < 16; ++i) { float a = qs[row * 65 + part * 16 + i], c = ks[row * 65 + part * 16 + i]; sq += a * a; sk += c * c; }
    sq += __shfl_xor(sq, 1); sq += __shfl_xor(sq, 2); sk += __shfl_xor(sk, 1); sk += __shfl_xor(sk, 2);
    float rq = rsqrtf(sq + 1e-6f) * 0.125f, rk = rsqrtf(sk + 1e-6f);
#pragma unroll
    for (int i = 0; i < 16; ++i) { qs[row * 65 + part * 16 + i] *= rq; ks[row * 65 + part * 16 + i] *= rk; }
  }
  __syncthreads();
  {
    int ti = tid >> 4, tj = tid & 15;
    float kk[4][4], qk[4][4];
#pragma unroll
    for (int a = 0; a < 4; ++a)
#pragma unroll
      for (int c = 0; c < 4; ++c) { kk[a][c] = 0.f; qk[a][c] = 0.f; }
    if (tj <= ti) {
      for (int d = 0; d < 64; ++d) {
        float ki[4], qi[4], kj[4];
#pragma unroll
        for (int a = 0; a < 4; ++a) { ki[a] = ks[(ti * 4 + a) * 65 + d]; qi[a] = qs[(ti * 4 + a) * 65 + d]; kj[a] = ks[(tj * 4 + a) * 65 + d]; }
#pragma unroll
        for (int a = 0; a < 4; ++a)
#pragma unroll
          for (int c = 0; c < 4; ++c) { kk[a][c] += ki[a] * kj[c]; qk[a][c] += qi[a] * kj[c]; }
      }
    }
#pragma unroll
    for (int a = 0; a < 4; ++a) {
      int i = ti * 4 + a;
      u16 av[4];
#pragma unroll
      for (int c = 0; c < 4; ++c) {
        int j = tj * 4 + c;
        float dec = (j <= i) ? expf(Gs[i] - Gs[j]) : 0.f;
        As[i * 64 + j] = (j < i) ? betas[i] * kk[a][c] * dec : 0.f;
        av[c] = f2bf((j <= i) ? qk[a][c] * dec : 0.f);
      }
      *(uint2*)(at_o + i * 64 + tj * 4) = make_uint2((unsigned)av[0] | ((unsigned)av[1] << 16), (unsigned)av[2] | ((unsigned)av[3] << 16));
    }
  }
  __syncthreads();
  {
    int d = tid & 63, ig = tid >> 6;
    for (int ii = 0; ii < 16; ++ii) { int i = ig * 16 + ii; qd_o[i * 64 + d] = f2bf(qs[i * 65 + d] * eGs[i]); }
    int li = tid & 63;
    float kd = expf(Gs[63] - Gs[li]);
    for (int dd = 0; dd < 16; ++dd) { int dcol = ig * 16 + dd; kd_o[dcol * 64 + li] = f2bf(ks[li * 65 + dcol] * kd); }
    if (tid == 0) ((float*)(p.ws + OFF_GL))[item] = eGs[63];
  }
  __syncthreads();
  {
    int d = tid & 63, ig = tid >> 6;
    for (int ii = 0; ii < 16; ++ii) { int i = ig * 16 + ii; float bt = betas[i]; vs[i * 65 + d] *= bt; ks[i * 65 + d] *= bt * eGs[i]; }
  }
  __syncthreads();
  {
    int c = tid >> 1, half = tid & 1, cc = c & 63;
    float* buf = (c < 64) ? vs : ks;
    for (int i = 1; i < 64; ++i) {
      float s = 0.f;
      float s1 = 0.f; int j = half;
      for (; j + 2 < i; j += 4) { s += As[i * 64 + j] * buf[j * 65 + cc]; s1 += As[i * 64 + j + 2] * buf[(j + 2) * 65 + cc]; }
      for (; j < i; j += 2) s += As[i * 64 + j] * buf[j * 65 + cc];
      s += s1;
      s += __shfl_xor(s, 1);
      if (half == 0) buf[i * 65 + cc] -= s;
    }
  }
  __syncthreads();
  {
    int d = tid & 63, ig = tid >> 6;
    for (int ii = 0; ii < 16; ++ii) { int i = ig * 16 + ii; u_o[i * 64 + d] = f2bf(vs[i * 65 + d]); w_o[i * 64 + d] = f2bf(ks[i * 65 + d]); }
  }
}

__device__ void gdn_scan_item(const Params& p, int l, int bh, unsigned char* smem) {
  int b = bh / 6, h = bh % 6, tid = get_tid(), wid = tid >> 6, lane = tid & 63, fr = lane & 15, fq = lane >> 4;
  u16* Ws = (u16*)smem; u16* Us = Ws + 64 * 72; u16* ATs = Us + 64 * 72; u16* QDs = ATs + 64 * 72; u16* KDs = QDs + 64 * 72;
  u16* STs = KDs + 64 * 72; u16* VTs = STs + 64 * 72;
  u16* proj = (u16*)(p.ws + OFF_PROJ);
  const u16* gi = (const u16*)(p.ws + OFF_GDNI) + (size_t)bh * 128 * GDNI_STRIDE;
  const float* glast = (const float*)(p.ws + OFF_GL) + bh * 128;
  const float* gnorm = p.gdn_norm + l * 64;
  f32x4 st[4];
#pragma unroll
  for (int i = 0; i < 4; ++i) st[i] = (f32x4){0.f, 0.f, 0.f, 0.f};
  __syncthreads();
  for (int i = tid; i < 64 * 72; i += NT) STs[i] = 0;
  u32x4 pre[10], prb[10];
#pragma unroll
  for (int i = 0; i < 10; ++i) pre[i] = *(const u32x4*)(gi + (size_t)(i * 256 + tid) * 8);
#pragma unroll
  for (int i = 0; i < 10; ++i) { int q = i * 256 + tid; int mat = q >> 9, r = (q >> 3) & 63, c = q & 7; *(u32x4*)(Ws + mat * 64 * 72 + r * 72 + c * 8) = pre[i]; }
  __syncthreads();
  {
    const u16* g1 = gi + (size_t)GDNI_STRIDE;
#pragma unroll
    for (int i = 0; i < 10; ++i) pre[i] = *(const u32x4*)(g1 + (size_t)(i * 256 + tid) * 8);
  }
  auto step = [&](int n, u32x4 (&LD)[10], u32x4 (&WR)[10]) {
    if (n + 2 < 128) {
      const u16* g2 = gi + (size_t)(n + 2) * GDNI_STRIDE;
#pragma unroll
      for (int i = 0; i < 10; ++i) LD[i] = *(const u32x4*)(g2 + (size_t)(i * 256 + tid) * 8);
    }
    float gl = ld_agent(&glast[n]);
    unsigned zr[4][2];
#pragma unroll
    for (int j = 0; j < 4; ++j) {
      size_t row = (size_t)b * SEQ + n * 64 + 16 * wid + fq * 4 + j;
#pragma unroll
      for (int k = 0; k < 2; ++k)
        zr[j][k] = (unsigned)proj[row * PROJ_LD + 2176 + h * 64 + (2 * k) * 16 + fr] | ((unsigned)proj[row * PROJ_LD + 2176 + h * 64 + (2 * k + 1) * 16 + fr] << 16);
    }
    f32x4 c1[4];
#pragma unroll
    for (int i = 0; i < 4; ++i) c1[i] = (f32x4){0.f, 0.f, 0.f, 0.f};
#pragma unroll
    for (int ks = 0; ks < 2; ++ks) {
      bf16x8 a = ldfrag72(STs, 16 * wid + fr, ks, fq);
#pragma unroll
      for (int nt = 0; nt < 4; ++nt) c1[nt] = mfma16(a, ldfrag72(Ws, nt * 16 + fr, ks, fq), c1[nt]);
    }
#pragma unroll
    for (int nt = 0; nt < 4; ++nt) {
      int l_ = nt * 16 + fr;
      uint2 u4 = *(const uint2*)(Us + l_ * 72 + 16 * wid + fq * 4);
      u16 uu[4] = {(u16)(u4.x & 0xffffu), (u16)(u4.x >> 16), (u16)(u4.y & 0xffffu), (u16)(u4.y >> 16)};
#pragma unroll
      for (int j = 0; j < 4; ++j) { int e = 16 * wid + fq * 4 + j; VTs[e * 72 + l_] = f2bf(bf2f(uu[j]) - c1[nt][j]); }
    }
    __syncthreads();
    f32x4 o[4];
#pragma unroll
    for (int i = 0; i < 4; ++i) o[i] = (f32x4){0.f, 0.f, 0.f, 0.f};
#pragma unroll
    for (int ks = 0; ks < 2; ++ks) {
      bf16x8 a = ldfrag72(QDs, 16 * wid + fr, ks, fq);
#pragma unroll
      for (int nt = 0; nt < 4; ++nt) o[nt] = mfma16(a, ldfrag72(STs, nt * 16 + fr, ks, fq), o[nt]);
    }
#pragma unroll
    for (int ks = 0; ks < 2; ++ks) {
      bf16x8 a = ldfrag72(ATs, 16 * wid + fr, ks, fq);
#pragma unroll
      for (int nt = 0; nt < 4; ++nt) o[nt] = mfma16(a, ldfrag72(VTs, nt * 16 + fr, ks, fq), o[nt]);
    }
#pragma unroll
    for (int j = 0; j < 4; ++j) {
      float ss = o[0][j] * o[0][j] + o[1][j] * o[1][j] + o[2][j] * o[2][j] + o[3][j] * o[3][j];
      ss = red16_sum(ss);
      float rms = rsqrtf(ss * (1.f / 64.f) + 1e-6f);
      size_t row = (size_t)b * SEQ + n * 64 + 16 * wid + fq * 4 + j;
#pragma unroll
      for (int nt = 0; nt < 4; ++nt) {
        size_t idx = row * PROJ_LD + 2176 + h * 64 + nt * 16 + fr;
        float z = bf2f((u16)(zr[j][nt >> 1] >> ((nt & 1) * 16)));
        proj[idx] = f2bf(o[nt][j] * rms * gnorm[nt * 16 + fr] * siluf(z));
      }
    }
#pragma unroll
    for (int nt = 0; nt < 4; ++nt) { st[nt][0] *= gl; st[nt][1] *= gl; st[nt][2] *= gl; st[nt][3] *= gl; }
#pragma unroll
    for (int ks = 0; ks < 2; ++ks) {
      bf16x8 a = ldfrag72(VTs, 16 * wid + fr, ks, fq);
#pragma unroll
      for (int nt = 0; nt < 4; ++nt) st[nt] = mfma16(a, ldfrag72(KDs, nt * 16 + fr, ks, fq), st[nt]);
    }
    __syncthreads();
#pragma unroll
    for (int nt = 0; nt < 4; ++nt)
#pragma unroll
      for (int j = 0; j < 4; ++j) STs[(16 * wid + fq * 4 + j) * 72 + nt * 16 + fr] = f2bf(st[nt][j]);
    if (n + 1 < 128) {
#pragma unroll
      for (int i = 0; i < 10; ++i) { int q = i * 256 + tid; int mat = q >> 9, r = (q >> 3) & 63, c = q & 7; *(u32x4*)(Ws + mat * 64 * 72 + r * 72 + c * 8) = WR[i]; }
    }
    __syncthreads();
  };
  for (int n = 0; n < 128; n += 2) { step(n, prb, pre); step(n + 1, pre, prb); }
}

__device__ void mlstm_local_item(const Params& p, int l, int item, unsigned char* smem) {
  int n = item & 127, bh = item >> 7, b = bh / 6, h = bh % 6, tid = get_tid();
  float* qs = (float*)smem; float* ks = qs + 64 * 65;
  float* bcs = ks + 64 * 65; float* ips = bcs + 64; float* mts = ips + 64; float* sws = mts + 64;
  const u16* proj = (const u16*)(p.ws + OFF_PROJ);
  const float* gates = (const float*)(p.ws + OFF_GATES);
  unsigned char* ob = p.ws + OFF_MLI + (size_t)item * MLI_STRIDE;
  u16 *qc_o = (u16*)ob, *P_o = qc_o + 4096, *sk_o = P_o + 4096;
  float* vec = (float*)(ob + 24576);
  const float* mch = (const float*)(p.ws + OFF_MCH) + bh * 129;
  int t0 = n * 64;
  __syncthreads();
  const float* cw = p.mlstm_conv + (size_t)l * 4 * 768;
  conv_silu_tile(proj, b, t0, 1152 + h * 64, cw, 768, h * 64, qs, 1.f);
  conv_silu_tile(proj, b, t0, 1536 + h * 64, cw, 768, 384 + h * 64, ks, 0.125f);
  if (tid < 64) {
    size_t row = (size_t)b * SEQ + t0 + tid;
    float ip = ld_agent(&gates[row * 24 + 12 + h]) + p.mlstm_i_bias[l * 6 + h];
    float lf = logsigf(ld_agent(&gates[row * 24 + 18 + h]) + p.mlstm_f_bias[l * 6 + h]);
    float bc = lf;
#pragma unroll
    for (int o = 1; o < 64; o <<= 1) { float t = __shfl_up(bc, o); if (tid >= o) bc += t; }
    float pm = ip - bc;
#pragma unroll
    for (int o = 1; o < 64; o <<= 1) { float t = __shfl_up(pm, o); if (tid >= o) pm = fmaxf(pm, t); }
    {
      const int* mflag = (const int*)(p.ws + OFF_CTR) + 512 + l * 32 + bh;
      while (__hip_atomic_load(mflag, __ATOMIC_RELAXED, __HIP_MEMORY_SCOPE_AGENT) == 0) __builtin_amdgcn_s_sleep(8);
      __builtin_amdgcn_fence(__ATOMIC_ACQUIRE, "agent");
      asm volatile("s_waitcnt vmcnt(0)" ::: "memory");
    }
    float m_in = ld_agent(&mch[n]), m_new = ld_agent(&mch[n + 1]);
    float inter = bc + m_in;
    float mt = fmaxf(inter, bc + pm);
    float bL = __shfl(bc, 63);
    float wend = bL - bc + ip;
    bcs[tid] = bc; ips[tid] = ip; mts[tid] = mt; sws[tid] = expf(wend - m_new);
    vec[tid] = expf(inter - mt);
    vec[64 + tid] = expf(-mt);
    if (tid == 0) vec[256] = expf(bL + m_in - m_new);
  }
  __syncthreads();
  {
    int ti = tid >> 4, tj = tid & 15;
    float qk[4][4];
#pragma unroll
    for (int a = 0; a < 4; ++a)
#pragma unroll
      for (int c = 0; c < 4; ++c) qk[a][c] = 0.f;
    if (tj <= ti) {
      for (int d = 0; d < 64; ++d) {
        float qi[4], kj[4];
#pragma unroll
        for (int a = 0; a < 4; ++a) { qi[a] = qs[(ti * 4 + a) * 65 + d]; kj[a] = ks[(tj * 4 + a) * 65 + d]; }
#pragma unroll
        for (int a = 0; a < 4; ++a)
#pragma unroll
          for (int c = 0; c < 4; ++c) qk[a][c] += qi[a] * kj[c];
      }
    }
#pragma unroll
    for (int a = 0; a < 4; ++a) {
      int i = ti * 4 + a;
      u16 pv[4]; float rs = 0.f;
#pragma unroll
      for (int c = 0; c < 4; ++c) {
        int j = tj * 4 + c;
        float pe = (j <= i) ? qk[a][c] * expf(bcs[i] - bcs[j] + ips[j] - mts[i]) : 0.f;
        rs += pe; pv[c] = f2bf(pe);
      }
      *(uint2*)(P_o + i * 64 + tj * 4) = make_uint2((unsigned)pv[0] | ((unsigned)pv[1] << 16), (unsigned)pv[2] | ((unsigned)pv[3] << 16));
      rs = red16_sum(rs);
      if (tj == 0) vec[128 + i] = rs;
    }
  }
  {
    int d = tid & 63, ig = tid >> 6;
    for (int ii = 0; ii < 16; ++ii) { int i = ig * 16 + ii; qc_o[i * 64 + d] = f2bf(qs[i * 65 + d]); }
    int li = tid & 63;
    float sw = sws[li];
    for (int dd = 0; dd < 16; ++dd) { int dcol = ig * 16 + dd; sk_o[dcol * 64 + li] = f2bf(sw * ks[li * 65 + dcol]); }
    if (tid < 64) {
      float s = 0.f;
      for (int i = 0; i < 64; ++i) s += sws[i] * ks[i * 65 + tid];
      vec[192 + tid] = s;
    }
  }
}

__device__ void mlstm_scan_item(const Params& p, int l, int bh, unsigned char* smem) {
  int b = bh / 6, h = bh % 6, tid = get_tid(), wid = tid >> 6, lane = tid & 63, fr = lane & 15, fq = lane >> 4;
  u16* QCs = (u16*)smem; u16* Ps = QCs + 64 * 72; u16* SKs = Ps + 64 * 72; u16* VTs = SKs + 64 * 72; u16* CTs = VTs + 64 * 72;
  float* nvec = (float*)(CTs + 64 * 72); float* qn = nvec + 64; float* vecs = qn + 64;
  u16* proj = (u16*)(p.ws + OFF_PROJ);
  const unsigned char* mi = p.ws + OFF_MLI + (size_t)bh * 128 * MLI_STRIDE;
  const u16* vct = (const u16*)(p.ws + OFF_VCT) + (size_t)bh * 64 * SEQ;
  const float* mnorm = p.mlstm_norm + l * 384 + h * 64;
  f32x4 ct[4];
#pragma unroll
  for (int i = 0; i < 4; ++i) ct[i] = (f32x4){0.f, 0.f, 0.f, 0.f};
  __syncthreads();
  for (int i = tid; i < 64 * 72; i += NT) CTs[i] = 0;
  if (tid < 64) nvec[tid] = 0.f;
  u32x4 pre[8]; f32x4 prev = (f32x4){0.f, 0.f, 0.f, 0.f};
  {
    const u16* g2 = (const u16*)mi;
#pragma unroll
    for (int i = 0; i < 6; ++i) pre[i] = *(const u32x4*)(g2 + (size_t)(i * 256 + tid) * 8);
#pragma unroll
    for (int i = 0; i < 2; ++i) { int q = i * 256 + tid; int r = q >> 3, c = q & 7; pre[6 + i] = *(const u32x4*)(vct + (size_t)r * SEQ + c * 8); }
    if (tid < 80) prev = *(const f32x4*)(mi + 24576 + tid * 16);
#pragma unroll
    for (int i = 0; i < 6; ++i) { int q = i * 256 + tid; int mat = q >> 9, r = (q >> 3) & 63, c = q & 7; *(u32x4*)(QCs + mat * 64 * 72 + r * 72 + c * 8) = pre[i]; }
#pragma unroll
    for (int i = 0; i < 2; ++i) { int q = i * 256 + tid; int r = q >> 3, c = q & 7; *(u32x4*)(VTs + r * 72 + c * 8) = pre[6 + i]; }
    if (tid < 80) *(f32x4*)(vecs + tid * 4) = prev;
  }
  __syncthreads();
  auto step = [&](int n, u32x4 (&LD)[8], f32x4& LDV, u32x4 (&WR)[8], f32x4& WRV) {
    if (n + 1 < 128) {
      const unsigned char* m2 = mi + (size_t)(n + 1) * MLI_STRIDE;
      const u16* g2 = (const u16*)m2;
#pragma unroll
      for (int i = 0; i < 6; ++i) LD[i] = *(const u32x4*)(g2 + (size_t)(i * 256 + tid) * 8);
#pragma unroll
      for (int i = 0; i < 2; ++i) { int q = i * 256 + tid; int r = q >> 3, c = q & 7; LD[6 + i] = *(const u32x4*)(vct + (size_t)r * SEQ + (n + 1) * 64 + c * 8); }
      if (tid < 80) LDV = *(const f32x4*)(m2 + 24576 + tid * 16);
    }
    unsigned orw[4][2];
#pragma unroll
    for (int j = 0; j < 4; ++j) {
      size_t row = (size_t)b * SEQ + n * 64 + 16 * wid + fq * 4 + j;
#pragma unroll
      for (int k = 0; k < 2; ++k)
        orw[j][k] = (unsigned)proj[row * PROJ_LD + 2816 + h * 64 + (2 * k) * 16 + fr] | ((unsigned)proj[row * PROJ_LD + 2816 + h * 64 + (2 * k + 1) * 16 + fr] << 16);
    }
    {
      int l_ = tid >> 2, part = tid & 3;
      float s = 0.f;
#pragma unroll
      for (int i = 0; i < 16; ++i) s += bf2f(QCs[l_ * 72 + part * 16 + i]) * nvec[part * 16 + i];
      s += __shfl_xor(s, 1); s += __shfl_xor(s, 2);
      if (part == 0) qn[l_] = s;
    }
    __syncthreads();
    float decay = vecs[256];
    f32x4 a1[4], a2[4];
#pragma unroll
    for (int i = 0; i < 4; ++i) { a1[i] = (f32x4){0.f, 0.f, 0.f, 0.f}; a2[i] = (f32x4){0.f, 0.f, 0.f, 0.f}; }
#pragma unroll
    for (int ks = 0; ks < 2; ++ks) {
      bf16x8 a = ldfrag72(QCs, 16 * wid + fr, ks, fq);
#pragma unroll
      for (int nt = 0; nt < 4; ++nt) a1[nt] = mfma16(a, ldfrag72(CTs, nt * 16 + fr, ks, fq), a1[nt]);
    }
#pragma unroll
    for (int ks = 0; ks < 2; ++ks) {
      bf16x8 a = ldfrag72(Ps, 16 * wid + fr, ks, fq);
#pragma unroll
      for (int nt = 0; nt < 4; ++nt) a2[nt] = mfma16(a, ldfrag72(VTs, nt * 16 + fr, ks, fq), a2[nt]);
    }
#pragma unroll
    for (int j = 0; j < 4; ++j) {
      int l_ = 16 * wid + fq * 4 + j;
      float ai = vecs[l_], en = vecs[64 + l_], rs = vecs[128 + l_];
      float den = ai * qn[l_] + rs;
      float dn = fmaxf(fabsf(den), en);
      float inv = 1.f / dn;
      size_t row = (size_t)b * SEQ + n * 64 + l_;
      float hv[4]; float s = 0.f;
#pragma unroll
      for (int nt = 0; nt < 4; ++nt) {
        size_t idx = row * PROJ_LD + 2816 + h * 64 + nt * 16 + fr;
        float og = sigmf(bf2f((u16)(orw[j][nt >> 1] >> ((nt & 1) * 16))));
        hv[nt] = (ai * a1[nt][j] + a2[nt][j]) * inv * og;
        s += hv[nt];
      }
      s = red16_sum(s);
      float mu = s * (1.f / 64.f);
      float q = 0.f;
#pragma unroll
      for (int nt = 0; nt < 4; ++nt) { float d = hv[nt] - mu; q += d * d; }
      q = red16_sum(q);
      float rstd = rsqrtf(q * (1.f / 64.f) + 1e-6f);
#pragma unroll
      for (int nt = 0; nt < 4; ++nt) {
        size_t idx = row * PROJ_LD + 2816 + h * 64 + nt * 16 + fr;
        proj[idx] = f2bf((hv[nt] - mu) * rstd * mnorm[nt * 16 + fr]);
      }
    }
#pragma unroll
    for (int nt = 0; nt < 4; ++nt) { ct[nt][0] *= decay; ct[nt][1] *= decay; ct[nt][2] *= decay; ct[nt][3] *= decay; }
#pragma unroll
    for (int ks = 0; ks < 2; ++ks) {
      bf16x8 a = ldfrag72(VTs, 16 * wid + fr, ks, fq);
#pragma unroll
      for (int nt = 0; nt < 4; ++nt) ct[nt] = mfma16(a, ldfrag72(SKs, nt * 16 + fr, ks, fq), ct[nt]);
    }
    float nnew = 0.f;
    if (tid < 64) nnew = decay * nvec[tid] + vecs[192 + tid];
    __syncthreads();
#pragma unroll
    for (int nt = 0; nt < 4; ++nt)
#pragma unroll
      for (int j = 0; j < 4; ++j) CTs[(16 * wid + fq * 4 + j) * 72 + nt * 16 + fr] = f2bf(ct[nt][j]);
    if (tid < 64) nvec[tid] = nnew;
    if (n + 1 < 128) {
#pragma unroll
      for (int i = 0; i < 6; ++i) { int q = i * 256 + tid; int mat = q >> 9, r = (q >> 3) & 63, c = q & 7; *(u32x4*)(QCs + mat * 64 * 72 + r * 72 + c * 8) = WR[i]; }
#pragma unroll
      for (int i = 0; i < 2; ++i) { int q = i * 256 + tid; int r = q >> 3, c = q & 7; *(u32x4*)(VTs + r * 72 + c * 8) = WR[6 + i]; }
      if (tid < 80) *(f32x4*)(vecs + tid * 4) = WRV;
    }
    __syncthreads();
  };
  for (int n = 0; n < 128; ++n) step(n, pre, prev, pre, prev);
}

__device__ __forceinline__ bool moba_next(int& blk, int& kt, int own, int nown, unsigned um) {
  ++kt;
  for (;;) {
    if (blk > own) return false;
    bool isown = (blk == own);
    bool sel = isown || ((um >> blk) & 1u);
    int ntile = isown ? nown : 4;
    if (sel && kt < ntile) return true;
    ++blk; kt = 0;
  }
}
__device__ void moba_item(const Params& p, int idx, unsigned char* smem) {
  int qt = 127 - (idx >> 4), bh = idx & 15, b = bh >> 2, h = bh & 3;
  int tid = get_tid(), wid = tid >> 6, lane = tid & 63, fr = lane & 15, fq = lane >> 4;
  int t0 = qt * 64, own = t0 >> 8;
  u16* KV = (u16*)smem;
  u16* Qs = KV + 4 * 64 * 72; u16* Ps = Qs + 64 * 72;
  float* km = (float*)(Ps + 64 * 72);
  float* gate = km + 32 * 64;
  unsigned* selm = (unsigned*)(gate + 64 * 33);
  unsigned* uni = selm + 64;
  u16* proj = (u16*)(p.ws + OFF_PROJ);
  const u16* vbt = (const u16*)(p.ws + OFF_VBT) + (size_t)bh * 64 * SEQ;
  const u16* kbase = proj + (size_t)b * SEQ * PROJ_LD + 1920 + h * 64;
  const float* kmean = (const float*)(p.ws + OFF_KMEAN) + (size_t)bh * 32 * 64;
  __syncthreads();
#pragma unroll
  for (int i = 0; i < 2; ++i) { int q = i * 256 + tid; int r = q >> 3, c = q & 7; *(u32x4*)(Qs + r * 72 + c * 8) = *(const u32x4*)(proj + ((size_t)b * SEQ + t0 + r) * PROJ_LD + 2560 + h * 64 + c * 8); }
  if (tid == 0) *uni = 0u;
  {
    const float* gm = (const float*)(p.ws + OFF_GM) + ((size_t)b * SEQ + t0) * 128 + h * 32;
    for (int i = tid; i < 64 * 32; i += NT) { int q = i >> 5, nb = i & 31; if (nb < own) gate[q * 33 + nb] = gm[(size_t)q * 128 + nb]; }
  }
  __syncthreads();
  if (tid < 64) {
    unsigned m = 0u;
    for (int r = 0; r < 3; ++r) {
      float best = -INFINITY; int bi = -1;
      for (int nb = 0; nb < own; ++nb) { float gv = gate[tid * 33 + nb]; if (!((m >> nb) & 1u) && gv > best) { best = gv; bi = nb; } }
      if (bi >= 0) m |= (1u << bi);
    }
    selm[tid] = m;
    if (m) atomicOr(uni, m);
  }
  __syncthreads();
  unsigned um = *uni;
  bf16x8 qf[2];
  qf[0] = ldfrag72(Qs, 16 * wid + fr, 0, fq); qf[1] = ldfrag72(Qs, 16 * wid + fr, 1, fq);
  unsigned mysel[4]; float mrun[4], lrun[4];
#pragma unroll
  for (int j = 0; j < 4; ++j) { mysel[j] = selm[16 * wid + fq * 4 + j]; mrun[j] = -INFINITY; lrun[j] = 0.f; }
  f32x4 o[4];
#pragma unroll
  for (int i = 0; i < 4; ++i) o[i] = (f32x4){0.f, 0.f, 0.f, 0.f};
  int nown = ((t0 - own * 256) >> 6) + 1;
  int blk = 0, kt = -1;
  bool have = moba_next(blk, kt, own, nown, um);
  u32x4 pk[2], pv[2];
  {
    int key0 = blk * 256 + kt * 64;
#pragma unroll
    for (int i = 0; i < 2; ++i) {
      int q = i * 256 + tid; int r = q >> 3, c = q & 7;
      pk[i] = *(const u32x4*)(kbase + (size_t)(key0 + r) * PROJ_LD + c * 8);
      pv[i] = *(const u32x4*)(vbt + (size_t)r * SEQ + key0 + c * 8);
    }
#pragma unroll
    for (int i = 0; i < 2; ++i) {
      int q = i * 256 + tid; int r = q >> 3, c = q & 7;
      *(u32x4*)(KV + r * 72 + c * 8) = pk[i];
      *(u32x4*)(KV + 64 * 72 + r * 72 + c * 8) = pv[i];
    }
  }
  __syncthreads();
  int it = 0;
  while (have) {
    int cblk = blk, ckt = kt;
    bool hn = moba_next(blk, kt, own, nown, um);
    if (hn) {
      int key0n = blk * 256 + kt * 64;
#pragma unroll
      for (int i = 0; i < 2; ++i) {
        int q = i * 256 + tid; int r = q >> 3, c = q & 7;
        pk[i] = *(const u32x4*)(kbase + (size_t)(key0n + r) * PROJ_LD + c * 8);
        pv[i] = *(const u32x4*)(vbt + (size_t)r * SEQ + key0n + c * 8);
      }
    }
    const u16* Ks = KV + (it & 1) * 2 * 64 * 72; const u16* Vts = Ks + 64 * 72;
    bool isown = (cblk == own);
    int key0 = cblk * 256 + ckt * 64;
    f32x4 s[4];
#pragma unroll
    for (int i = 0; i < 4; ++i) s[i] = (f32x4){0.f, 0.f, 0.f, 0.f};
#pragma unroll
    for (int ks = 0; ks < 2; ++ks)
#pragma unroll
      for (int nt = 0; nt < 4; ++nt) s[nt] = mfma16(qf[ks], ldfrag72(Ks, nt * 16 + fr, ks, fq), s[nt]);
#pragma unroll
    for (int j = 0; j < 4; ++j) {
      int qpos = t0 + 16 * wid + fq * 4 + j;
      bool rowok = isown ? true : (((mysel[j] >> cblk) & 1u) != 0u);
      float mx = -INFINITY;
#pragma unroll
      for (int nt = 0; nt < 4; ++nt) {
        int key = key0 + nt * 16 + fr;
        bool ok = isown ? (key <= qpos) : rowok;
        float v = ok ? s[nt][j] * 0.125f : -INFINITY;
        s[nt][j] = v; mx = fmaxf(mx, v);
      }
      mx = red16_max(mx);
      float mnew = fmaxf(mrun[j], mx);
      float msafe = (mnew == -INFINITY) ? 0.f : mnew;
      float sc = __expf(mrun[j] - msafe);
      float ps = 0.f;
#pragma unroll
      for (int nt = 0; nt < 4; ++nt) { float pe = __expf(s[nt][j] - msafe); ps += pe; s[nt][j] = pe; }
      ps = red16_sum(ps);
      lrun[j] = lrun[j] * sc + ps; mrun[j] = mnew;
#pragma unroll
      for (int nt = 0; nt < 4; ++nt) o[nt][j] *= sc;
    }
#pragma unroll
    for (int nt = 0; nt < 4; ++nt)
#pragma unroll
      for (int j = 0; j < 4; ++j) Ps[(16 * wid + fq * 4 + j) * 72 + nt * 16 + fr] = f2bf(s[nt][j]);
    asm volatile("s_waitcnt lgkmcnt(0)" ::: "memory");
#pragma unroll
    for (int ks = 0; ks < 2; ++ks) {
      bf16x8 a = ldfrag72(Ps, 16 * wid + fr, ks, fq);
#pragma unroll
      for (int nt = 0; nt < 4; ++nt) o[nt] = mfma16(a, ldfrag72(Vts, nt * 16 + fr, ks, fq), o[nt]);
    }
    if (hn) {
      u16* Kn = KV + ((it + 1) & 1) * 2 * 64 * 72;
#pragma unroll
      for (int i = 0; i < 2; ++i) {
        int q = i * 256 + tid; int r = q >> 3, c = q & 7;
        *(u32x4*)(Kn + r * 72 + c * 8) = pk[i];
        *(u32x4*)(Kn + 64 * 72 + r * 72 + c * 8) = pv[i];
      }
    }
    __syncthreads();
    have = hn; ++it;
  }
#pragma unroll
  for (int j = 0; j < 4; ++j) {
    float inv = 1.f / lrun[j];
    size_t row = (size_t)b * SEQ + t0 + 16 * wid + fq * 4 + j;
#pragma unroll
    for (int nt = 0; nt < 4; ++nt) proj[row * PROJ_LD + 2560 + h * 64 + nt * 16 + fr] = f2bf(o[nt][j] * inv);
  }
}

__device__ __forceinline__ void grid_barrier(unsigned* bar, unsigned target) {
  asm volatile("s_waitcnt vmcnt(0) lgkmcnt(0)" ::: "memory");
  __syncthreads();
  if (threadIdx.x == 0) {
    __builtin_amdgcn_fence(__ATOMIC_RELEASE, "agent");
    asm volatile("s_waitcnt vmcnt(0)" ::: "memory");
    __hip_atomic_fetch_add(bar, 1u, __ATOMIC_RELAXED, __HIP_MEMORY_SCOPE_AGENT);
    while (__hip_atomic_load(bar, __ATOMIC_RELAXED, __HIP_MEMORY_SCOPE_AGENT) < target) __builtin_amdgcn_s_sleep(2);
    __builtin_amdgcn_fence(__ATOMIC_ACQUIRE, "agent");
    asm volatile("s_waitcnt vmcnt(0)" ::: "memory");
  }
  __syncthreads();
  asm volatile("buffer_inv sc1\n\ts_waitcnt vmcnt(0)" ::: "memory");
}

__global__ void __launch_bounds__(NT, 2) fwd_megakernel(Params p) {
  __shared__ __attribute__((aligned(16))) unsigned char smem[SMEM_BYTES];
  cg::grid_group grid = cg::this_grid();
  int* ctr = (int*)(p.ws + OFF_CTR);
  u16* wt = (u16*)(p.ws + OFF_WT);
  u16* Abuf = (u16*)(p.ws + OFF_GDNI);
  u16* hbuf = (u16*)(p.ws + OFF_PROJ);
  int ph = 0;
#define PH_BEGIN if (ph >= p.ph_lo && ph < p.ph_hi) {
#define PH_END } ++ph; if (p.coop && ph > p.ph_lo && ph < p.ph_hi) { grid_barrier(gbar, (unsigned)(ph - p.ph_lo) * gridDim.x); }
  unsigned* gbar = (unsigned*)(p.ws + OFF_CTR) + 1024;
  if (p.coop) grid.sync();
  PH_BEGIN
    for (int it = blockIdx.x; it < 576 + NCONV_ITEMS; it += gridDim.x) {
      if (it < 576) modp_item(p, it, smem); else convert_item(p, 0, it - 576, smem);
    }
  PH_END
  PH_BEGIN
    mod_finalize(p);
  PH_END
  PH_BEGIN
    ln_phase(p, false, 0, 0, true, 0, 0);
  PH_END
  for (int l0 = 0; l0 < 2; ++l0) {
    int l = l0; asm volatile("" : "+s"(l));
    EpiArgs ea;
    PH_BEGIN
      ea.xres = nullptr; ea.l = l; ea.sub = 0; ea.gs = 0.f;
      gemm_phase<EPI_SWIGLU>(p, Abuf, DM, wt + WT13_OFF(0), 1024, 44, ea, smem, -1, true);
    PH_END
    PH_BEGIN
      ea.xres = (l == 0) ? p.x : p.out; ea.l = l; ea.sub = 0; ea.gs = 0.5f;
      gemm_phase<EPI_RES>(p, hbuf, DFF, wt + WT2_OFF(0), 2816, 8, ea, smem);
    PH_END
    PH_BEGIN
      ln_phase(p, true, l, 0, true, l, 1);
    PH_END
    PH_BEGIN
      for (int it = blockIdx.x; it < 512; it += gridDim.x) u_item(p, l, it, smem);
    PH_END
    PH_BEGIN
      ea.xres = nullptr; ea.l = l; ea.sub = 1; ea.gs = 0.f;
      gemm_phase<EPI_PROJ>(p, Abuf, DM, wt + WTIN_OFF, 1024, 31, ea, smem, -1, true);
      gemm_phase<EPI_PROJ>(p, Abuf, DM, wt + WTIN_OFF, 1024, 31, ea, smem, 31);
      { float* xbz = (float*)(p.ws + OFF_XBAR);
        for (int i = blockIdx.x * NT + get_tid(); i < 128 * 1024; i += gridDim.x * NT) xbz[i] = 0.f; }
    PH_END
    PH_BEGIN
      int* c = ctr + (l * 3 + 0) * 16;
      for (;;) {
        int it = next_item(c);
        if (it >= 24 + 3072 + 3072) break;
        if (it < 24) mchain_item(p, l, it, smem);
        else if (it < 3096) gdn_local_item(p, l, it - 24, smem);
        else mlstm_local_item(p, l, it - 3096, smem);
      }
    PH_END
    PH_BEGIN
      int* c = ctr + (l * 3 + 1) * 16;
      if (blockIdx.x < 24) { __builtin_amdgcn_s_setprio(3); gdn_scan_item(p, l, blockIdx.x, smem); __builtin_amdgcn_s_setprio(0); }
      else if (blockIdx.x < 48) { __builtin_amdgcn_s_setprio(3); mlstm_scan_item(p, l, blockIdx.x - 24, smem); __builtin_amdgcn_s_setprio(0); }
      if (!(gridDim.x == 512 && blockIdx.x >= 256 && blockIdx.x < 304))
      for (;;) {
        int it = next_item(c);
        if (it >= 2048) break;
        moba_item(p, it, smem);
      }
    PH_END
    PH_BEGIN
      ea.xres = p.out; ea.l = l; ea.sub = 1; ea.gs = 1.0f;
      gemm_phase<EPI_RES>(p, hbuf + 2176, PROJ_LD, wt + WTOUT_OFF, 1024, 8, ea, smem);
    PH_END
    PH_BEGIN
      ln_phase(p, true, l, 1, true, l, 2);
    PH_END
    PH_BEGIN
      ea.xres = nullptr; ea.l = l; ea.sub = 2; ea.gs = 0.f;
      gemm_phase<EPI_SWIGLU>(p, Abuf, DM, wt + WT13_OFF(1), 1024, 44, ea, smem, -1, true);
    PH_END
    PH_BEGIN
      ea.xres = p.out; ea.l = l; ea.sub = 2; ea.gs = 0.5f;
      gemm_phase<EPI_RES>(p, hbuf, DFF, wt + WT2_OFF(1), 2816, 8, ea, smem);
    PH_END
    PH_BEGIN
      ln_phase(p, true, l, 2, l == 0, 1, 0);
      if (l == 0) for (int it = blockIdx.x; it < NCONV_ITEMS; it += gridDim.x) convert_item(p, 1, it, smem);
    PH_END
  }
}

#define N_PHASES 27

extern "C" void kernel_launch(void* const* d_in, const int* in_sizes, int n_in, void* d_out, int out_size,
                              void* d_ws, size_t ws_size, hipStream_t stream) {
  static int grid_blocks = 0;
  if (!grid_blocks) {
    int dev = 0, cus = 0, per_cu = 0;
    hipGetDevice(&dev);
    hipDeviceGetAttribute(&cus, hipDeviceAttributeMultiprocessorCount, dev);
    hipOccupancyMaxActiveBlocksPerMultiprocessor(&per_cu, fwd_megakernel, NT, 0);
    if (per_cu > 2) per_cu = 2;
    if (per_cu < 1) per_cu = 1;
    grid_blocks = cus * per_cu;
  }
  if (ws_size < WS_NEEDED) { fprintf(stderr, "workspace too small: %zu\n", ws_size); return; }
  Params p{};
  const float** f = (const float**)d_in;
  p.x = f[0]; p.c = f[1]; p.ada_w = f[2]; p.ada_b = f[3]; p.w13 = f[4]; p.w2 = f[5]; p.w_in = f[6]; p.w_out = f[7];
  p.gdn_conv = f[8]; p.gdn_a_log = f[9]; p.gdn_dt_bias = f[10]; p.gdn_norm = f[11]; p.mlstm_conv = f[12];
  p.mlstm_i_bias = f[13]; p.mlstm_f_bias = f[14]; p.mlstm_norm = f[15]; p.ln_g = f[16]; p.ln_b = f[17];
  p.out = (float*)d_out; p.ws = (unsigned char*)d_ws;
  p.ph_lo = 0; p.ph_hi = N_PHASES; p.coop = 1; p.pad = 0;
  hipMemsetAsync((unsigned char*)d_ws + OFF_CTR, 0, 128 * 1024 + 512 * 1024, stream);
  void* args[] = {&p};
  hipError_t e = hipLaunchCooperativeKernel((void*)fwd_megakernel, dim3(grid_blocks), dim3(NT), args, 0, stream);
  if (e != hipSuccess) fprintf(stderr, "cooperative launch failed: %s (grid %d)\n", hipGetErrorString(e), grid_blocks);
}
```

```cpp
#include <hip/hip_runtime.h>
#include <hip/hip_cooperative_groups.h>
#include <cstdio>
namespace cg = cooperative_groups;

typedef unsigned short u16;
using bf16x8 = __attribute__((ext_vector_type(8))) short;
using f32x4  = __attribute__((ext_vector_type(4))) float;
using u32x4  = __attribute__((ext_vector_type(4))) unsigned;

#define NTOK 32768
#define SEQ 8192
#define DM 1024
#define DFF 2816
#define PROJ_LD 3200
#define NT 256
#define SMEM_BYTES 73728
#define ALPHA_F 1.4142135623730951f

#define MiB (1024ull*1024ull)
#define OFF_PROJ   (0ull)
#define OFF_GDNI   (200ull*MiB)
#define OFF_MLI    (320ull*MiB)
#define OFF_WT     (396ull*MiB)
#define OFF_VCT    (439ull*MiB)
#define OFF_VBT    (463ull*MiB)
#define OFF_GATES  (479ull*MiB)
#define OFF_MODP   (482ull*MiB)
#define OFF_MOD    (484ull*MiB + 512*1024)
#define OFF_KMEAN  (485ull*MiB)
#define OFF_MCH    (485ull*MiB + 256*1024)
#define OFF_GL     (485ull*MiB + 320*1024)
#define OFF_CTR    (485ull*MiB + 384*1024)
#define OFF_XBAR   (485ull*MiB + 512*1024)
#define OFF_UH     (486ull*MiB)
#define OFF_UL     (487ull*MiB)
#define OFF_GM     (488ull*MiB)
#define OFF_ALO    OFF_MLI
#define WS_NEEDED  (504ull*MiB)

#define GDNI_STRIDE 20480
#define MLI_STRIDE  25856

#define WT13_OFF(f) ((size_t)(f)*5632*1024)
#define WT2_OFF(f)  ((size_t)2*5632*1024 + (size_t)(f)*1024*2816)
#define WTIN_OFF    ((size_t)2*5632*1024 + (size_t)2*1024*2816)
#define WTOUT_OFF   (WTIN_OFF + (size_t)3968*1024)

struct Params {
  const float *x, *c, *ada_w, *ada_b, *w13, *w2, *w_in, *w_out, *gdn_conv, *gdn_a_log, *gdn_dt_bias, *gdn_norm,
              *mlstm_conv, *mlstm_i_bias, *mlstm_f_bias, *mlstm_norm, *ln_g, *ln_b;
  float* out;
  unsigned char* ws;
  int ph_lo, ph_hi, coop, pad;
};

__device__ __forceinline__ int get_tid() { int t = threadIdx.x; asm volatile("" : "+v"(t)); return t; }
__device__ __forceinline__ u16 f2bf(float f) {
  f = fminf(fmaxf(f, -65000.f), 65000.f);
  _Float16 h = (_Float16)f;
  return __builtin_bit_cast(u16, h);
}
__device__ __forceinline__ float bf2f(u16 h) { return (float)__builtin_bit_cast(_Float16, h); }
__device__ __forceinline__ float siluf(float x) { return x / (1.f + __expf(-x)); }
__device__ __forceinline__ float sigmf(float x) { return 1.f / (1.f + __expf(-x)); }
__device__ __forceinline__ float softplusf(float x) { return x > 20.f ? x : log1pf(expf(x)); }
__device__ __forceinline__ float logsigf(float x) { return fminf(x, 0.f) - log1pf(expf(-fabsf(x))); }
__device__ __forceinline__ bf16x8 ldfrag72(const u16* base, int row, int ks, int fq) {
  return *(const bf16x8*)(base + row * 72 + ks * 32 + fq * 8);
}
using f16x8 = __attribute__((ext_vector_type(8))) _Float16;
__device__ __forceinline__ f32x4 mfma16(bf16x8 a, bf16x8 b, f32x4 c) {
  return __builtin_amdgcn_mfma_f32_16x16x32_f16(__builtin_bit_cast(f16x8, a), __builtin_bit_cast(f16x8, b), c, 0, 0, 0);
}
template <int CTRL> __device__ __forceinline__ float dpp_mov(float v) {
  return __builtin_bit_cast(float, __builtin_amdgcn_update_dpp(0, __builtin_bit_cast(int, v), CTRL, 0xF, 0xF, true));
}
__device__ __forceinline__ float red16_sum(float v) {
  v += dpp_mov<0xB1>(v); v += dpp_mov<0x4E>(v); v += dpp_mov<0x124>(v); v += dpp_mov<0x128>(v); return v;
}
__device__ __forceinline__ float red16_max(float v) {
  v = fmaxf(v, dpp_mov<0xB1>(v)); v = fmaxf(v, dpp_mov<0x4E>(v)); v = fmaxf(v, dpp_mov<0x124>(v)); v = fmaxf(v, dpp_mov<0x128>(v)); return v;
}
__device__ __forceinline__ float mod_get(const Params& p, int l, int b, int j) {
  return ((const float*)(p.ws + OFF_MOD))[(size_t)(l * 4 + b) * 9216 + j];
}
__device__ void mod_finalize(const Params& p) {
  const float* mp = (const float*)(p.ws + OFF_MODP);
  float* mo = (float*)(p.ws + OFF_MOD);
  for (int i = blockIdx.x * NT + get_tid(); i < 2 * 4 * 9216; i += gridDim.x * NT) {
    int j = i % 9216, lb = i / 9216, l = lb >> 2, b = lb & 3;
    float s = p.ada_b[l * 9216 + j];
    for (int ks = 0; ks < 8; ++ks) s += mp[(size_t)((l * 8 + ks) * 4 + b) * 9216 + j];
    mo[i] = s;
  }
}
__device__ __forceinline__ float ld_agent(const float* p) { return __hip_atomic_load(p, __ATOMIC_RELAXED, __HIP_MEMORY_SCOPE_AGENT); }
__device__ __forceinline__ int next_item(int* ctr) {
  __shared__ int s_item;
  __syncthreads();
  if (get_tid() == 0) s_item = atomicAdd(ctr, 1);
  __syncthreads();
  return s_item;
}

__device__ void modp_item(const Params& p, int item, unsigned char* smem) {
  int ks = item & 7, jc = (item >> 3) % 36, l = item / 288;
  float* sc = (float*)smem;
  int tid = get_tid();
  __syncthreads();
  for (int i = tid; i < 512; i += NT) { int b = i >> 7, k = i & 127; float cv = p.c[b * DM + ks * 128 + k]; sc[i] = cv / (1.f + expf(-cv)); }
  __syncthreads();
  int j = jc * 256 + tid;
  const float* w = p.ada_w + ((size_t)l * DM + ks * 128) * 9216 + j;
  float a0 = 0, a1 = 0, a2 = 0, a3 = 0;
#pragma unroll 8
  for (int k = 0; k < 128; ++k) { float wv = w[(size_t)k * 9216]; a0 += sc[k] * wv; a1 += sc[128 + k] * wv; a2 += sc[256 + k] * wv; a3 += sc[384 + k] * wv; }
  float* mp = (float*)(p.ws + OFF_MODP) + (size_t)((l * 8 + ks) * 4) * 9216 + j;
  mp[0] = a0; mp[9216] = a1; mp[2 * 9216] = a2; mp[3 * 9216] = a3;
}

__device__ __forceinline__ int win_map(int r) {
  if (r < 1152) return r;
  if (r < 2304) return 2316 + (r - 1152);
  if (r < 2560) return 1804 + (r - 2304);
  if (r < 2816) return 2060 + (r - 2560);
  if (r < 3200) return 1164 + (r - 2816);
  if (r < 3456) return 1548 + (r - 3200);
  if (r < 3840) return 3480 + (r - 3456);
  if (r < 3852) return 1152 + (r - 3840);
  if (r < 3864) return 3468 + (r - 3852);
  return -1;
}
#define NCONV_ITEMS 5472
__device__ void convert_item(const Params& p, int l, int idx, unsigned char* smem) {
  float* t = (float*)smem;
  int tid = get_tid();
  const float* src; u16* dst; int Nsrc, K, n0, k0, mode;
  u16* wt = (u16*)(p.ws + OFF_WT);
  if (idx < 2816) { int f = idx / 1408, r = idx % 1408; n0 = (r / 16) * 64; k0 = (r % 16) * 64; src = p.w13 + (size_t)(l * 2 + f) * 1024 * 5632; Nsrc = 5632; K = 1024; dst = wt + WT13_OFF(f); mode = 1; }
  else if (idx < 4224) { int q = idx - 2816; int f = q / 704, r = q % 704; n0 = (r / 44) * 64; k0 = (r % 44) * 64; src = p.w2 + (size_t)(l * 2 + f) * 2816 * 1024; Nsrc = 1024; K = 2816; dst = wt + WT2_OFF(f); mode = 0; }
  else if (idx < 5216) { int r = idx - 4224; n0 = (r / 16) * 64; k0 = (r % 16) * 64; src = p.w_in + (size_t)l * 1024 * 3864; Nsrc = 3864; K = 1024; dst = wt + WTIN_OFF; mode = 2; }
  else { int r = idx - 5216; n0 = (r / 16) * 64; k0 = (r % 16) * 64; src = p.w_out + (size_t)l * 1024 * 1024; Nsrc = 1024; K = 1024; dst = wt + WTOUT_OFF; mode = 0; }
  __syncthreads();
  {
    int c = tid & 63, kr = tid >> 6;
    int nd = n0 + c, ns;
    if (mode == 0) ns = nd;
    else if (mode == 1) { int grp = nd >> 6, w = nd & 63; ns = grp * 32 + (w & 31) + ((w & 32) ? 2816 : 0); }
    else ns = win_map(nd);
#pragma unroll 4
    for (int it = 0; it < 16; ++it) {
      int kk = it * 4 + kr;
      float v = (ns >= 0) ? src[(size_t)(k0 + kk) * Nsrc + ns] : 0.f;
      t[kk * 65 + c] = v;
    }
  }
  __syncthreads();
  {
    int n = tid >> 2, kq = tid & 3;
    unsigned pk[8];
#pragma unroll
    for (int i = 0; i < 8; ++i) {
      u16 lo = f2bf(t[(kq * 16 + 2 * i) * 65 + n]);
      u16 hi = f2bf(t[(kq * 16 + 2 * i + 1) * 65 + n]);
      pk[i] = (unsigned)lo | ((unsigned)hi << 16);
    }
    uint4* o = (uint4*)(dst + (size_t)(n0 + n) * K + k0 + kq * 16);
    o[0] = make_uint4(pk[0], pk[1], pk[2], pk[3]);
    o[1] = make_uint4(pk[4], pk[5], pk[6], pk[7]);
  }
}

__device__ void ln_phase(const Params& p, bool do_ln, int lg, int sg, bool do_a, int l2, int sub2) {
  int tid = get_tid(), lane = tid & 63;
  int gw = blockIdx.x * 4 + (tid >> 6), GW = gridDim.x * 4;
  int R = (NTOK + GW - 1) / GW;
  int r0 = gw * R, r1 = min(r0 + R, NTOK);
  const float* src = do_ln ? p.out : p.x;
  u16* A = (u16*)(p.ws + OFF_GDNI);
  float g[16], bb[16], sh[16], sc[16];
  if (do_ln) {
#pragma unroll
    for (int i = 0; i < 4; ++i)
#pragma unroll
      for (int e = 0; e < 4; ++e) { int col = i * 256 + lane * 4 + e; g[i * 4 + e] = p.ln_g[(lg * 3 + sg) * DM + col]; bb[i * 4 + e] = p.ln_b[(lg * 3 + sg) * DM + col]; }
  }
  int curb = -1;
  float xs[16];
#pragma unroll
  for (int i = 0; i < 16; ++i) xs[i] = 0.f;
  int xblk = -1;
  for (int r = r0; r < r1; ++r) {
    int b = r / SEQ;
    if (do_a && b != curb) {
      curb = b;
#pragma unroll
      for (int i = 0; i < 4; ++i)
#pragma unroll
        for (int e = 0; e < 4; ++e) { int col = i * 256 + lane * 4 + e; sh[i * 4 + e] = mod_get(p, l2, b, sub2 * 3072 + col); sc[i * 4 + e] = 1.f + mod_get(p, l2, b, sub2 * 3072 + 1024 + col); }
    }
    float v[16];
#pragma unroll
    for (int i = 0; i < 4; ++i) { float4 t = *(const float4*)(src + (size_t)r * DM + i * 256 + lane * 4); v[i * 4] = t.x; v[i * 4 + 1] = t.y; v[i * 4 + 2] = t.z; v[i * 4 + 3] = t.w; }
    if (do_ln) {
      float s = 0;
#pragma unroll
      for (int i = 0; i < 16; ++i) s += v[i];
#pragma unroll
      for (int o = 1; o < 64; o <<= 1) s += __shfl_xor(s, o);
      float mu = s * (1.f / 1024.f);
      float q = 0;
#pragma unroll
      for (int i = 0; i < 16; ++i) { float d = v[i] - mu; q += d * d; }
#pragma unroll
      for (int o = 1; o < 64; o <<= 1) q += __shfl_xor(q, o);
      float rs = rsqrtf(q * (1.f / 1024.f) + 1e-5f);
#pragma unroll
      for (int i = 0; i < 16; ++i) v[i] = (v[i] - mu) * rs * g[i] + bb[i];
#pragma unroll
      for (int i = 0; i < 4; ++i) *(float4*)(p.out + (size_t)r * DM + i * 256 + lane * 4) = make_float4(v[i * 4], v[i * 4 + 1], v[i * 4 + 2], v[i * 4 + 3]);
    }
    if (do_a && sub2 == 1) {
      u16* Alo = (u16*)(p.ws + OFF_ALO);
      int blk = r >> 8;
      if (blk != xblk) {
        if (xblk >= 0) {
          float* xb = (float*)(p.ws + OFF_XBAR) + (size_t)xblk * DM;
#pragma unroll
          for (int i = 0; i < 4; ++i)
#pragma unroll
            for (int e = 0; e < 4; ++e) { atomicAdd(xb + i * 256 + lane * 4 + e, xs[i * 4 + e]); xs[i * 4 + e] = 0.f; }
        }
        xblk = blk;
      }
#pragma unroll
      for (int i = 0; i < 4; ++i) {
        u16 lo[4];
#pragma unroll
        for (int e = 0; e < 4; ++e) {
          float xm = v[i * 4 + e] * sc[i * 4 + e] + sh[i * 4 + e];
          xs[i * 4 + e] += xm;
          lo[e] = f2bf(xm - bf2f(f2bf(xm)));
        }
        *(uint2*)(Alo + (size_t)r * DM + i * 256 + lane * 4) = make_uint2((unsigned)lo[0] | ((unsigned)lo[1] << 16), (unsigned)lo[2] | ((unsigned)lo[3] << 16));
      }
    }
    if (do_a) {
#pragma unroll
      for (int i = 0; i < 4; ++i) {
        u16 a0 = f2bf(v[i * 4] * sc[i * 4] + sh[i * 4]), a1 = f2bf(v[i * 4 + 1] * sc[i * 4 + 1] + sh[i * 4 + 1]);
        u16 a2 = f2bf(v[i * 4 + 2] * sc[i * 4 + 2] + sh[i * 4 + 2]), a3 = f2bf(v[i * 4 + 3] * sc[i * 4 + 3] + sh[i * 4 + 3]);
        *(uint2*)(A + (size_t)r * DM + i * 256 + lane * 4) = make_uint2((unsigned)a0 | ((unsigned)a1 << 16), (unsigned)a2 | ((unsigned)a3 << 16));
      }
    }
  }
  if (xblk >= 0) {
    float* xb = (float*)(p.ws + OFF_XBAR) + (size_t)xblk * DM;
#pragma unroll
    for (int i = 0; i < 4; ++i)
#pragma unroll
      for (int e = 0; e < 4; ++e) atomicAdd(xb + i * 256 + lane * 4 + e, xs[i * 4 + e]);
  }
}

__device__ void u_item(const Params& p, int l, int item, unsigned char* smem) {
  int h = item & 3, nb = (item >> 2) & 31, b = item >> 7, tid = get_tid();
  float* xb = (float*)smem; float* red = xb + 1024; float* kb = red + 256;
  const float* XB = (const float*)(p.ws + OFF_XBAR) + (size_t)(b * 32 + nb) * DM;
  const float* W = p.w_in + (size_t)l * 1024 * 3864;
  __syncthreads();
  for (int i = tid; i < 1024; i += NT) xb[i] = XB[i] * (1.f / 256.f);
  __syncthreads();
  {
    int j = tid & 63, kq = tid >> 6;
    const float* wk = W + (size_t)(kq * 256) * 3864 + 1804 + h * 64 + j;
    float s = 0.f;
#pragma unroll 8
    for (int k = 0; k < 256; ++k) s += xb[kq * 256 + k] * wk[(size_t)k * 3864];
    red[kq * 64 + j] = s;
  }
  __syncthreads();
  if (tid < 64) kb[tid] = red[tid] + red[64 + tid] + red[128 + tid] + red[192 + tid];
  __syncthreads();
  u16* UH = (u16*)(p.ws + OFF_UH) + ((size_t)b * 128 + h * 32 + nb) * 1024;
  u16* UL = (u16*)(p.ws + OFF_UL) + ((size_t)b * 128 + h * 32 + nb) * 1024;
  for (int i = 0; i < 4; ++i) {
    int k = i * 256 + tid;
    const float* wq = W + (size_t)k * 3864 + 1548 + h * 64;
    float s = 0.f;
#pragma unroll
    for (int j = 0; j < 64; j += 4) { float4 wv = *(const float4*)(wq + j); s += wv.x * kb[j] + wv.y * kb[j + 1] + wv.z * kb[j + 2] + wv.w * kb[j + 3]; }
    u16 hi = f2bf(s);
    UH[k] = hi; UL[k] = f2bf(s - bf2f(hi));
  }
}

enum { EPI_SWIGLU = 0, EPI_RES = 1, EPI_PROJ = 2 };
struct EpiArgs { const float* xres; int l, sub; float gs; };

__device__ __forceinline__ void gemm_stage(const u16* A, int lda, const u16* Bt, int K, int brow, int bcol, int kt, unsigned char* buf) {
  int tid = get_tid();
#pragma unroll
  for (int i = 0; i < 4; ++i) {
    int pidx = i * 256 + tid; int r = pidx >> 3, cp = pidx & 7; int cl = cp ^ ((r >> 1) & 7);
    __builtin_amdgcn_global_load_lds((const unsigned*)(A + (size_t)(brow + r) * lda + kt * 64 + cl * 8), (unsigned*)(buf + pidx * 16), 16, 0, 0);
  }
#pragma unroll
  for (int i = 0; i < 4; ++i) {
    int pidx = i * 256 + tid; int r = pidx >> 3, cp = pidx & 7; int cl = cp ^ ((r >> 1) & 7);
    __builtin_amdgcn_global_load_lds((const unsigned*)(Bt + (size_t)(bcol + r) * K + kt * 64 + cl * 8), (unsigned*)(buf + 16384 + pidx * 16), 16, 0, 0);
  }
}
__device__ __forceinline__ bf16x8 ldfrag_sw(const unsigned char* buf, int row, int cl) {
  return *(const bf16x8*)(buf + row * 128 + ((cl ^ ((row >> 1) & 7)) << 4));
}

template <int MODE>
__device__ void gemm_phase(const Params& p, const u16* A, int lda, const u16* Bt, int K, int ntn, EpiArgs ea, unsigned char* smem, int nt_fixed = -1, bool xcd_patch = false) {
  int tid = get_tid(), wid = tid >> 6, lane = tid & 63, wr = wid >> 1, wc = wid & 1, fr = lane & 15, fq = lane >> 4;
  int ntiles = (nt_fixed >= 0) ? 256 : 256 * ntn, nk = K / 64;
  int tstart = (nt_fixed >= 0) ? (int)((blockIdx.x + gridDim.x - (256 % gridDim.x)) % gridDim.x) : (int)blockIdx.x;
  bool patch = xcd_patch && nt_fixed < 0 && (gridDim.x & 7) == 0;
  int px = blockIdx.x & 7, pn0 = (ntn * (px & 3)) >> 2, png = ((ntn * ((px & 3) + 1)) >> 2) - pn0;
  int tstep = gridDim.x;
  if (patch) { tstart = blockIdx.x >> 3; ntiles = 128 * png; tstep = gridDim.x >> 3; }
  for (int t = tstart; t < ntiles; t += tstep) {
    int g = t / (8 * ntn), r = t % (8 * ntn);
    int mt = g * 8 + (r & 7), nt = r >> 3;
    if (nt_fixed >= 0) { mt = t; nt = nt_fixed; }
    if (patch) { mt = (px >> 2) * 128 + t / png; nt = pn0 + t % png; }
    int brow = mt * 128, bcol = nt * 128;
    f32x4 acc[4][4];
#pragma unroll
    for (int m = 0; m < 4; ++m)
#pragma unroll
      for (int n = 0; n < 4; ++n) acc[m][n] = (f32x4){0.f, 0.f, 0.f, 0.f};
    int b = brow / SEQ;
    const u16* B0 = Bt; const u16* B2 = Bt; const u16* A1 = A; int bc = bcol, npass = 1;
    if (MODE == EPI_PROJ && nt == 31) {
      B0 = (const u16*)(p.ws + OFF_UH) + (size_t)b * 128 * 1024; B2 = (const u16*)(p.ws + OFF_UL) + (size_t)b * 128 * 1024;
      A1 = (const u16*)(p.ws + OFF_ALO); bc = 0; npass = 3;
    }
    int nkt = nk * npass;
    __syncthreads();
    gemm_stage(A, lda, B0, K, brow, bc, 0, smem);
    for (int kt = 0; kt < nkt; ++kt) {
      asm volatile("s_waitcnt vmcnt(0)" ::: "memory");
      __syncthreads();
      unsigned char* cur = smem + (kt & 1) * 32768;
      if (kt + 1 < nkt) {
        int ps = (kt + 1) / nk, kk = (kt + 1) - ps * nk;
        gemm_stage(ps == 1 ? A1 : A, lda, ps == 2 ? B2 : B0, K, brow, bc, kk, smem + ((kt + 1) & 1) * 32768);
      }
#pragma unroll
      for (int ks = 0; ks < 2; ++ks) {
        bf16x8 af[4], bfr[4];
#pragma unroll
        for (int m = 0; m < 4; ++m) af[m] = ldfrag_sw(cur, wr * 64 + m * 16 + fr, ks * 4 + fq);
#pragma unroll
        for (int n = 0; n < 4; ++n) bfr[n] = ldfrag_sw(cur + 16384, wc * 64 + n * 16 + fr, ks * 4 + fq);
#pragma unroll
        for (int m = 0; m < 4; ++m)
#pragma unroll
          for (int n = 0; n < 4; ++n) acc[m][n] = mfma16(af[m], bfr[n], acc[m][n]);
      }
    }
    if (MODE == EPI_SWIGLU) {
      u16* hbuf = (u16*)(p.ws + OFF_PROJ);
#pragma unroll
      for (int m = 0; m < 4; ++m)
#pragma unroll
        for (int n = 0; n < 2; ++n) {
          int hid = (nt * 2 + wc) * 32 + n * 16 + fr;
#pragma unroll
          for (int j = 0; j < 4; ++j) {
            int row = brow + wr * 64 + m * 16 + fq * 4 + j;
            float a = acc[m][n][j], bv = acc[m][n + 2][j];
            hbuf[(size_t)row * DFF + hid] = f2bf(siluf(a) * bv);
          }
        }
    } else if (MODE == EPI_RES) {
#pragma unroll
      for (int n = 0; n < 4; ++n) {
        int col = bcol + wc * 64 + n * 16 + fr;
        float gate = ea.gs * (1.f + mod_get(p, ea.l, b, ea.sub * 3072 + 2048 + col));
#pragma unroll
        for (int m = 0; m < 4; ++m)
#pragma unroll
          for (int j = 0; j < 4; ++j) {
            int row = brow + wr * 64 + m * 16 + fq * 4 + j;
            size_t idx = (size_t)row * DM + col;
            p.out[idx] = ALPHA_F * ea.xres[idx] + gate * acc[m][n][j];
          }
      }
    } else {
      u16* proj = (u16*)(p.ws + OFF_PROJ);
      if (nt == 31) {
        float* gm = (float*)(p.ws + OFF_GM);
#pragma unroll
        for (int n = 0; n < 4; ++n) {
          int gc = wc * 64 + n * 16 + fr;
#pragma unroll
          for (int m = 0; m < 4; ++m)
#pragma unroll
            for (int j = 0; j < 4; ++j) { int row = brow + wr * 64 + m * 16 + fq * 4 + j; gm[(size_t)row * 128 + gc] = acc[m][n][j]; }
        }
      } else if (nt == 30) {
        float* gates = (float*)(p.ws + OFF_GATES);
#pragma unroll
        for (int n = 0; n < 4; ++n) {
          int gc = wc * 64 + n * 16 + fr;
          if (gc < 24) {
#pragma unroll
            for (int m = 0; m < 4; ++m)
#pragma unroll
              for (int j = 0; j < 4; ++j) { int row = brow + wr * 64 + m * 16 + fq * 4 + j; gates[(size_t)row * 24 + gc] = acc[m][n][j]; }
          }
        }
      } else if ((nt >= 15 && nt <= 17) || nt == 20 || nt == 21) {
        bool isc = nt < 18;
        u16* vt = (u16*)(p.ws + (isc ? OFF_VCT : OFF_VBT));
        int H = isc ? 6 : 4, cb = isc ? 1920 : 2560;
#pragma unroll
        for (int n = 0; n < 4; ++n) {
          int cc = bcol + wc * 64 + n * 16 + fr - cb; int head = cc >> 6, e = cc & 63;
#pragma unroll
          for (int m = 0; m < 4; ++m) {
            int tt = (brow - b * SEQ) + wr * 64 + m * 16 + fq * 4;
            u16 v0 = f2bf(acc[m][n][0]), v1 = f2bf(acc[m][n][1]), v2 = f2bf(acc[m][n][2]), v3 = f2bf(acc[m][n][3]);
            *(uint2*)(vt + ((size_t)(b * H + head) * 64 + e) * SEQ + tt) = make_uint2((unsigned)v0 | ((unsigned)v1 << 16), (unsigned)v2 | ((unsigned)v3 << 16));
          }
        }
      } else {
        int shift = nt < 15 ? 0 : (nt < 20 ? 384 : 640);
#pragma unroll
        for (int n = 0; n < 4; ++n) {
          int pc = bcol + wc * 64 + n * 16 + fr - shift;
#pragma unroll
          for (int m = 0; m < 4; ++m)
#pragma unroll
            for (int j = 0; j < 4; ++j) { int row = brow + wr * 64 + m * 16 + fq * 4 + j; proj[(size_t)row * PROJ_LD + pc] = f2bf(acc[m][n][j]); }
        }
      }
    }
  }
}

__device__ void mchain_item(const Params& p, int l, int bh, unsigned char* smem) {
  int b = bh / 6, h = bh % 6, tid = get_tid();
  float* bLs = (float*)smem; float* mws = bLs + 128;
  const float* gates = (const float*)(p.ws + OFF_GATES);
  __syncthreads();
  if (tid < 128) {
    float ib = p.mlstm_i_bias[l * 6 + h], fb = p.mlstm_f_bias[l * 6 + h];
    float bc = 0.f, mx = -INFINITY;
    size_t row = (size_t)b * SEQ + tid * 64;
#pragma unroll 8
    for (int s = 0; s < 64; ++s) {
      float ip = gates[(row + s) * 24 + 12 + h] + ib;
      float lf = logsigf(gates[(row + s) * 24 + 18 + h] + fb);
      bc += lf; mx = fmaxf(mx, ip - bc);
    }
    bLs[tid] = bc; mws[tid] = bc + mx;
  }
  __syncthreads();
  if (tid == 0) {
    float* mch = (float*)(p.ws + OFF_MCH) + bh * 129;
    float m = 0.f;
    for (int n = 0; n < 128; ++n) { __hip_atomic_store(&mch[n], m, __ATOMIC_RELAXED, __HIP_MEMORY_SCOPE_AGENT); m = fmaxf(bLs[n] + m, mws[n]); }
    __hip_atomic_store(&mch[128], m, __ATOMIC_RELAXED, __HIP_MEMORY_SCOPE_AGENT);
    __builtin_amdgcn_fence(__ATOMIC_RELEASE, "agent");
    asm volatile("s_waitcnt vmcnt(0)" ::: "memory");
    __hip_atomic_store((int*)(p.ws + OFF_CTR) + 512 + l * 32 + bh, 1, __ATOMIC_RELAXED, __HIP_MEMORY_SCOPE_AGENT);
  }
}

__device__ void kmean_item(const Params& p, int item, unsigned char* smem) {
  int nb = item & 31, bh = item >> 5, b = bh >> 2, h = bh & 3, tid = get_tid();
  float* red = (float*)smem;
  const u16* proj = (const u16*)(p.ws + OFF_PROJ);
  int d = tid & 63, part = tid >> 6;
  float s = 0.f;
  for (int k = 0; k < 64; ++k) s += bf2f(proj[((size_t)b * SEQ + nb * 256 + part * 64 + k) * PROJ_LD + 1920 + h * 64 + d]);
  __syncthreads();
  red[tid] = s;
  __syncthreads();
  if (tid < 64) ((float*)(p.ws + OFF_KMEAN))[(size_t)item * 64 + tid] = (red[tid] + red[64 + tid] + red[128 + tid] + red[192 + tid]) * (1.f / 256.f);
}

__device__ __forceinline__ void conv_silu_tile(const u16* proj, int b, int t0, int pcol, const float* cw, int cwld, int ccol, float* dst, float post) {
  int tid = get_tid(), d = tid & 63, rg = tid >> 6;
  float w0 = cw[ccol + d], w1 = cw[cwld + ccol + d], w2 = cw[2 * cwld + ccol + d], w3 = cw[3 * cwld + ccol + d];
  int tl0 = t0 + rg * 16;
  const u16* base = proj + (size_t)b * SEQ * PROJ_LD + pcol + d;
  float xm3 = (tl0 - 3 >= 0) ? bf2f(base[(size_t)(tl0 - 3) * PROJ_LD]) : 0.f;
  float xm2 = (tl0 - 2 >= 0) ? bf2f(base[(size_t)(tl0 - 2) * PROJ_LD]) : 0.f;
  float xm1 = (tl0 - 1 >= 0) ? bf2f(base[(size_t)(tl0 - 1) * PROJ_LD]) : 0.f;
  float xr[16];
#pragma unroll
  for (int i = 0; i < 16; ++i) xr[i] = bf2f(base[(size_t)(tl0 + i) * PROJ_LD]);
#pragma unroll
  for (int i = 0; i < 16; ++i) {
    float x0 = xr[i];
    float y = w0 * xm3 + w1 * xm2 + w2 * xm1 + w3 * x0;
    dst[(rg * 16 + i) * 65 + d] = siluf(y) * post;
    xm3 = xm2; xm2 = xm1; xm1 = x0;
  }
}

__device__ void gdn_local_item(const Params& p, int l, int item, unsigned char* smem) {
  int n = item & 127, bh = item >> 7, b = bh / 6, h = bh % 6, tid = get_tid();
  float* qs = (float*)smem; float* ks = qs + 64 * 65; float* vs = ks + 64 * 65; float* As = vs + 64 * 65;
  float* Gs = As + 64 * 64; float* betas = Gs + 64; float* eGs = betas + 64;
  const u16* proj = (const u16*)(p.ws + OFF_PROJ);
  const float* gates = (const float*)(p.ws + OFF_GATES);
  u16* outb = (u16*)(p.ws + OFF_GDNI) + (size_t)item * GDNI_STRIDE;
  u16 *w_o = outb, *u_o = outb + 4096, *at_o = outb + 8192, *qd_o = outb + 12288, *kd_o = outb + 16384;
  int t0 = n * 64;
  __syncthreads();
  const float* cw = p.gdn_conv + (size_t)l * 4 * 1152;
  conv_silu_tile(proj, b, t0, h * 64, cw, 1152, h * 64, qs, 1.f);
  conv_silu_tile(proj, b, t0, 384 + h * 64, cw, 1152, 384 + h * 64, ks, 1.f);
  conv_silu_tile(proj, b, t0, 768 + h * 64, cw, 1152, 768 + h * 64, vs, 1.f);
  if (tid < 64) {
    size_t row = (size_t)b * SEQ + t0 + tid;
    float a = ld_agent(&gates[row * 24 + h]), br = ld_agent(&gates[row * 24 + 6 + h]);
    float g = -expf(p.gdn_a_log[l * 6 + h]) * softplusf(a + p.gdn_dt_bias[l * 6 + h]);
    float beta = 1.f / (1.f + expf(-br));
    float G = g;
#pragma unroll
    for (int o = 1; o < 64; o <<= 1) { float t = __shfl_up(G, o); if (tid >= o) G += t; }
    Gs[tid] = G; betas[tid] = beta; eGs[tid] = expf(G);
  }
  __syncthreads();
  {
    int row = tid >> 2, part = tid & 3;
    float sq = 0.f, sk = 0.f;
#pragma unroll
    for (int i = 0; i < 16; ++i) { float a = qs[row * 65 + part * 16 + i], c = ks[row * 65 + part * 16 + i]; sq += a * a; sk += c * c; }
    sq += __shfl_xor(sq, 1); sq += __shfl_xor(sq, 2); sk += __shfl_xor(sk, 1); sk += __shfl_xor(sk, 2);
    float rq = rsqrtf(sq + 1e-6f) * 0.125f, rk = rsqrtf(sk + 1e-6f);
#pragma unroll
    for (int i = 0; i < 16; ++i) { qs[row * 65 + part * 16 + i] *= rq; ks[row * 65 + part * 16 + i] *= rk; }
  }
  __syncthreads();
  {
    int ti = tid >> 4, tj = tid & 15;
    float kk[4][4], qk[4][4];
#pragma unroll
    for (int a = 0; a < 4; ++a)
#pragma unroll
      for (int c = 0; c < 4; ++c) { kk[a][c] = 0.f; qk[a][c] = 0.f; }
    if (tj <= ti) {
      for (int d = 0; d < 64; ++d) {
        float ki[4], qi[4], kj[4];
#pragma unroll
        for (int a = 0; a < 4; ++a) { ki[a] = ks[(ti * 4 + a) * 65 + d]; qi[a] = qs[(ti * 4 + a) * 65 + d]; kj[a] = ks[(tj * 4 + a) * 65 + d]; }
#pragma unroll
        for (int a = 0; a < 4; ++a)
#pragma unroll
          for (int c = 0; c < 4; ++c) { kk[a][c] += ki[a] * kj[c]; qk[a][c] += qi[a] * kj[c]; }
      }
    }
#pragma unroll
    for (int a = 0; a < 4; ++a) {
      int i = ti * 4 + a;
      u16 av[4];
#pragma unroll
      for (int c = 0; c < 4; ++c) {
        int j = tj * 4 + c;
        float dec = (j <= i) ? expf(Gs[i] - Gs[j]) : 0.f;
        As[i * 64 + j] = (j < i) ? betas[i] * kk[a][c] * dec : 0.f;
        av[c] = f2bf((j <= i) ? qk[a][c] * dec : 0.f);
      }
      *(uint2*)(at_o + i * 64 + tj * 4) = make_uint2((unsigned)av[0] | ((unsigned)av[1] << 16), (unsigned)av[2] | ((unsigned)av[3] << 16));
    }
  }
  __syncthreads();
  {
    int d = tid & 63, ig = tid >> 6;
    for (int ii = 0; ii < 16; ++ii) { int i = ig * 16 + ii; qd_o[i * 64 + d] = f2bf(qs[i * 65 + d] * eGs[i]); }
    int li = tid & 63;
    float kd = expf(Gs[63] - Gs[li]);
    for (int dd = 0; dd < 16; ++dd) { int dcol = ig * 16 + dd; kd_o[dcol * 64 + li] = f2bf(ks[li * 65 + dcol] * kd); }
    if (tid == 0) ((float*)(p.ws + OFF_GL))[item] = eGs[63];
  }
  __syncthreads();
  {
    int d = tid & 63, ig = tid >> 6;
    for (int ii = 0; ii < 16; ++ii) { int i = ig * 16 + ii; float bt = betas[i]; vs[i * 65 + d] *= bt; ks[i * 65 + d] *= bt * eGs[i]; }
  }
  __syncthreads();
  {
    int c = tid >> 1, half = tid & 1, cc = c & 63;
    float* buf = (c < 64) ? vs : ks;
    for (int i = 1; i < 64; ++i) {
      float s = 0.f;
      float s1 = 0.f; int j = half;
      for (; j + 2 < i; j += 4) { s += As[i * 64 + j] * buf[j * 65 + cc]; s1 += As[i * 64 + j + 2] * buf[(j + 2) * 65 + cc]; }
      for (; j < i; j += 2) s += As[i * 64 + j] * buf[j * 65 + cc];
      s += s1;
      s += __shfl_xor(s, 1);
      if (half == 0) buf[i * 65 + cc] -= s;
    }
  }
  __syncthreads();
  {
    int d = tid & 63, ig = tid >> 6;
    for (int ii = 0; ii < 16; ++ii) { int i = ig * 16 + ii; u_o[i * 64 + d] = f2bf(vs[i * 65 + d]); w_o[i * 64 + d] = f2bf(ks[i * 65 + d]); }
  }
}

__device__ void gdn_scan_item(const Params& p, int l, int bh, unsigned char* smem) {
  int b = bh / 6, h = bh % 6, tid = get_tid(), wid = tid >> 6, lane = tid & 63, fr = lane & 15, fq = lane >> 4;
  u16* Ws = (u16*)smem; u16* Us = Ws + 64 * 72; u16* ATs = Us + 64 * 72; u16* QDs = ATs + 64 * 72; u16* KDs = QDs + 64 * 72;
  u16* STs = KDs + 64 * 72; u16* VTs = STs + 64 * 72;
  u16* proj = (u16*)(p.ws + OFF_PROJ);
  const u16* gi = (const u16*)(p.ws + OFF_GDNI) + (size_t)bh * 128 * GDNI_STRIDE;
  const float* glast = (const float*)(p.ws + OFF_GL) + bh * 128;
  const float* gnorm = p.gdn_norm + l * 64;
  f32x4 st[4];
#pragma unroll
  for (int i = 0; i < 4; ++i) st[i] = (f32x4){0.f, 0.f, 0.f, 0.f};
  __syncthreads();
  for (int i = tid; i < 64 * 72; i += NT) STs[i] = 0;
  u32x4 pre[10], prb[10];
#pragma unroll
  for (int i = 0; i < 10; ++i) pre[i] = *(const u32x4*)(gi + (size_t)(i * 256 + tid) * 8);
#pragma unroll
  for (int i = 0; i < 10; ++i) { int q = i * 256 + tid; int mat = q >> 9, r = (q >> 3) & 63, c = q & 7; *(u32x4*)(Ws + mat * 64 * 72 + r * 72 + c * 8) = pre[i]; }
  __syncthreads();
  {
    const u16* g1 = gi + (size_t)GDNI_STRIDE;
#pragma unroll
    for (int i = 0; i < 10; ++i) pre[i] = *(const u32x4*)(g1 + (size_t)(i * 256 + tid) * 8);
  }
  auto step = [&](int n, u32x4 (&LD)[10], u32x4 (&WR)[10]) {
    if (n + 2 < 128) {
      const u16* g2 = gi + (size_t)(n + 2) * GDNI_STRIDE;
#pragma unroll
      for (int i = 0; i < 10; ++i) LD[i] = *(const u32x4*)(g2 + (size_t)(i * 256 + tid) * 8);
    }
    float gl = ld_agent(&glast[n]);
    unsigned zr[4][2];
#pragma unroll
    for (int j = 0; j < 4; ++j) {
      size_t row = (size_t)b * SEQ + n * 64 + 16 * wid + fq * 4 + j;
#pragma unroll
      for (int k = 0; k < 2; ++k)
        zr[j][k] = (unsigned)proj[row * PROJ_LD + 2176 + h * 64 + (2 * k) * 16 + fr] | ((unsigned)proj[row * PROJ_LD + 2176 + h * 64 + (2 * k + 1) * 16 + fr] << 16);
    }
    f32x4 c1[4];
#pragma unroll
    for (int i = 0; i < 4; ++i) c1[i] = (f32x4){0.f, 0.f, 0.f, 0.f};
#pragma unroll
    for (int ks = 0; ks < 2; ++ks) {
      bf16x8 a = ldfrag72(STs, 16 * wid + fr, ks, fq);
#pragma unroll
      for (int nt = 0; nt < 4; ++nt) c1[nt] = mfma16(a, ldfrag72(Ws, nt * 16 + fr, ks, fq), c1[nt]);
    }
#pragma unroll
    for (int nt = 0; nt < 4; ++nt) {
      int l_ = nt * 16 + fr;
      uint2 u4 = *(const uint2*)(Us + l_ * 72 + 16 * wid + fq * 4);
      u16 uu[4] = {(u16)(u4.x & 0xffffu), (u16)(u4.x >> 16), (u16)(u4.y & 0xffffu), (u16)(u4.y >> 16)};
#pragma unroll
      for (int j = 0; j < 4; ++j) { int e = 16 * wid + fq * 4 + j; VTs[e * 72 + l_] = f2bf(bf2f(uu[j]) - c1[nt][j]); }
    }
    __syncthreads();
    if (n + 1 < 128) {
#pragma unroll
      for (int i = 0; i < 4; ++i) { int q = i * 256 + tid; int mat = q >> 9, r = (q >> 3) & 63, c = q & 7; *(u32x4*)(Ws + mat * 64 * 72 + r * 72 + c * 8) = WR[i]; }
    }
    f32x4 o[4];
#pragma unroll
    for (int i = 0; i < 4; ++i) o[i] = (f32x4){0.f, 0.f, 0.f, 0.f};
#pragma unroll
    for (int ks = 0; ks < 2; ++ks) {
      bf16x8 a = ldfrag72(QDs, 16 * wid + fr, ks, fq);
#pragma unroll
      for (int nt = 0; nt < 4; ++nt) o[nt] = mfma16(a, ldfrag72(STs, nt * 16 + fr, ks, fq), o[nt]);
    }
#pragma unroll
    for (int ks = 0; ks < 2; ++ks) {
      bf16x8 a = ldfrag72(ATs, 16 * wid + fr, ks, fq);
#pragma unroll
      for (int nt = 0; nt < 4; ++nt) o[nt] = mfma16(a, ldfrag72(VTs, nt * 16 + fr, ks, fq), o[nt]);
    }
#pragma unroll
    for (int j = 0; j < 4; ++j) {
      float ss = o[0][j] * o[0][j] + o[1][j] * o[1][j] + o[2][j] * o[2][j] + o[3][j] * o[3][j];
      ss = red16_sum(ss);
      float rms = rsqrtf(ss * (1.f / 64.f) + 1e-6f);
      size_t row = (size_t)b * SEQ + n * 64 + 16 * wid + fq * 4 + j;
#pragma unroll
      for (int nt = 0; nt < 4; ++nt) {
        size_t idx = row * PROJ_LD + 2176 + h * 64 + nt * 16 + fr;
        float z = bf2f((u16)(zr[j][nt >> 1] >> ((nt & 1) * 16)));
        proj[idx] = f2bf(o[nt][j] * rms * gnorm[nt * 16 + fr] * siluf(z));
      }
    }
#pragma unroll
    for (int nt = 0; nt < 4; ++nt) { st[nt][0] *= gl; st[nt][1] *= gl; st[nt][2] *= gl; st[nt][3] *= gl; }
#pragma unroll
    for (int ks = 0; ks < 2; ++ks) {
      bf16x8 a = ldfrag72(VTs, 16 * wid + fr, ks, fq);
#pragma unroll
      for (int nt = 0; nt < 4; ++nt) st[nt] = mfma16(a, ldfrag72(KDs, nt * 16 + fr, ks, fq), st[nt]);
    }
    __syncthreads();
#pragma unroll
    for (int nt = 0; nt < 4; ++nt)
#pragma unroll
      for (int j = 0; j < 4; ++j) STs[(16 * wid + fq * 4 + j) * 72 + nt * 16 + fr] = f2bf(st[nt][j]);
    if (n + 1 < 128) {
#pragma unroll
      for (int i = 4; i < 10; ++i) { int q = i * 256 + tid; int mat = q >> 9, r = (q >> 3) & 63, c = q & 7; *(u32x4*)(Ws + mat * 64 * 72 + r * 72 + c * 8) = WR[i]; }
    }
    asm volatile("s_waitcnt lgkmcnt(0)" ::: "memory");
  };
  for (int n = 0; n < 128; n += 2) { step(n, prb, pre); step(n + 1, pre, prb); }
}

__device__ void mlstm_local_item(const Params& p, int l, int item, unsigned char* smem) {
  int n = item & 127, bh = item >> 7, b = bh / 6, h = bh % 6, tid = get_tid();
  float* qs = (float*)smem; float* ks = qs + 64 * 65;
  float* bcs = ks + 64 * 65; float* ips = bcs + 64; float* mts = ips + 64; float* sws = mts + 64;
  const u16* proj = (const u16*)(p.ws + OFF_PROJ);
  const float* gates = (const float*)(p.ws + OFF_GATES);
  unsigned char* ob = p.ws + OFF_MLI + (size_t)item * MLI_STRIDE;
  u16 *qc_o = (u16*)ob, *P_o = qc_o + 4096, *sk_o = P_o + 4096;
  float* vec = (float*)(ob + 24576);
  const float* mch = (const float*)(p.ws + OFF_MCH) + bh * 129;
  int t0 = n * 64;
  __syncthreads();
  const float* cw = p.mlstm_conv + (size_t)l * 4 * 768;
  conv_silu_tile(proj, b, t0, 1152 + h * 64, cw, 768, h * 64, qs, 1.f);
  conv_silu_tile(proj, b, t0, 1536 + h * 64, cw, 768, 384 + h * 64, ks, 0.125f);
  if (tid < 64) {
    size_t row = (size_t)b * SEQ + t0 + tid;
    float ip = ld_agent(&gates[row * 24 + 12 + h]) + p.mlstm_i_bias[l * 6 + h];
    float lf = logsigf(ld_agent(&gates[row * 24 + 18 + h]) + p.mlstm_f_bias[l * 6 + h]);
    float bc = lf;
#pragma unroll
    for (int o = 1; o < 64; o <<= 1) { float t = __shfl_up(bc, o); if (tid >= o) bc += t; }
    float pm = ip - bc;
#pragma unroll
    for (int o = 1; o < 64; o <<= 1) { float t = __shfl_up(pm, o); if (tid >= o) pm = fmaxf(pm, t); }
    {
      const int* mflag = (const int*)(p.ws + OFF_CTR) + 512 + l * 32 + bh;
      while (__hip_atomic_load(mflag, __ATOMIC_RELAXED, __HIP_MEMORY_SCOPE_AGENT) == 0) __builtin_amdgcn_s_sleep(8);
      __builtin_amdgcn_fence(__ATOMIC_ACQUIRE, "agent");
      asm volatile("s_waitcnt vmcnt(0)" ::: "memory");
    }
    float m_in = ld_agent(&mch[n]), m_new = ld_agent(&mch[n + 1]);
    float inter = bc + m_in;
    float mt = fmaxf(inter, bc + pm);
    float bL = __shfl(bc, 63);
    float wend = bL - bc + ip;
    bcs[tid] = bc; ips[tid] = ip; mts[tid] = mt; sws[tid] = expf(wend - m_new);
    vec[tid] = expf(inter - mt);
    vec[64 + tid] = expf(-mt);
    if (tid == 0) vec[256] = expf(bL + m_in - m_new);
  }
  __syncthreads();
  {
    int ti = tid >> 4, tj = tid & 15;
    float qk[4][4];
#pragma unroll
    for (int a = 0; a < 4; ++a)
#pragma unroll
      for (int c = 0; c < 4; ++c) qk[a][c] = 0.f;
    if (tj <= ti) {
      for (int d = 0; d < 64; ++d) {
        float qi[4], kj[4];
#pragma unroll
        for (int a = 0; a < 4; ++a) { qi[a] = qs[(ti * 4 + a) * 65 + d]; kj[a] = ks[(tj * 4 + a) * 65 + d]; }
#pragma unroll
        for (int a = 0; a < 4; ++a)
#pragma unroll
          for (int c = 0; c < 4; ++c) qk[a][c] += qi[a] * kj[c];
      }
    }
#pragma unroll
    for (int a = 0; a < 4; ++a) {
      int i = ti * 4 + a;
      u16 pv[4]; float rs = 0.f;
#pragma unroll
      for (int c = 0; c < 4; ++c) {
        int j = tj * 4 + c;
        float pe = (j <= i) ? qk[a][c] * expf(bcs[i] - bcs[j] + ips[j] - mts[i]) : 0.f;
        rs += pe; pv[c] = f2bf(pe);
      }
      *(uint2*)(P_o + i * 64 + tj * 4) = make_uint2((unsigned)pv[0] | ((unsigned)pv[1] << 16), (unsigned)pv[2] | ((unsigned)pv[3] << 16));
      rs = red16_sum(rs);
      if (tj == 0) vec[128 + i] = rs;
    }
  }
  {
    int d = tid & 63, ig = tid >> 6;
    for (int ii = 0; ii < 16; ++ii) { int i = ig * 16 + ii; qc_o[i * 64 + d] = f2bf(qs[i * 65 + d]); }
    int li = tid & 63;
    float sw = sws[li];
    for (int dd = 0; dd < 16; ++dd) { int dcol = ig * 16 + dd; sk_o[dcol * 64 + li] = f2bf(sw * ks[li * 65 + dcol]); }
    if (tid < 64) {
      float s = 0.f;
      for (int i = 0; i < 64; ++i) s += sws[i] * ks[i * 65 + tid];
      vec[192 + tid] = s;
    }
  }
}

__device__ void mlstm_scan_item(const Params& p, int l, int bh, unsigned char* smem) {
  int b = bh / 6, h = bh % 6, tid = get_tid(), wid = tid >> 6, lane = tid & 63, fr = lane & 15, fq = lane >> 4;
  u16* QCs = (u16*)smem; u16* Ps = QCs + 64 * 72; u16* SKs = Ps + 64 * 72; u16* VTs = SKs + 64 * 72; u16* CTs = VTs + 64 * 72;
  float* nvec = (float*)(CTs + 64 * 72); float* qn = nvec + 64; float* vecs = qn + 64;
  u16* proj = (u16*)(p.ws + OFF_PROJ);
  const unsigned char* mi = p.ws + OFF_MLI + (size_t)bh * 128 * MLI_STRIDE;
  const u16* vct = (const u16*)(p.ws + OFF_VCT) + (size_t)bh * 64 * SEQ;
  const float* mnorm = p.mlstm_norm + l * 384 + h * 64;
  f32x4 ct[4];
#pragma unroll
  for (int i = 0; i < 4; ++i) ct[i] = (f32x4){0.f, 0.f, 0.f, 0.f};
  __syncthreads();
  for (int i = tid; i < 64 * 72; i += NT) CTs[i] = 0;
  if (tid < 64) nvec[tid] = 0.f;
  u32x4 pre[8]; f32x4 prev = (f32x4){0.f, 0.f, 0.f, 0.f};
  {
    const u16* g2 = (const u16*)mi;
#pragma unroll
    for (int i = 0; i < 6; ++i) pre[i] = *(const u32x4*)(g2 + (size_t)(i * 256 + tid) * 8);
#pragma unroll
    for (int i = 0; i < 2; ++i) { int q = i * 256 + tid; int r = q >> 3, c = q & 7; pre[6 + i] = *(const u32x4*)(vct + (size_t)r * SEQ + c * 8); }
    if (tid < 80) prev = *(const f32x4*)(mi + 24576 + tid * 16);
#pragma unroll
    for (int i = 0; i < 6; ++i) { int q = i * 256 + tid; int mat = q >> 9, r = (q >> 3) & 63, c = q & 7; *(u32x4*)(QCs + mat * 64 * 72 + r * 72 + c * 8) = pre[i]; }
#pragma unroll
    for (int i = 0; i < 2; ++i) { int q = i * 256 + tid; int r = q >> 3, c = q & 7; *(u32x4*)(VTs + r * 72 + c * 8) = pre[6 + i]; }
    if (tid < 80) *(f32x4*)(vecs + tid * 4) = prev;
  }
  __syncthreads();
  auto step = [&](int n, u32x4 (&LD)[8], f32x4& LDV, u32x4 (&WR)[8], f32x4& WRV) {
    if (n + 1 < 128) {
      const unsigned char* m2 = mi + (size_t)(n + 1) * MLI_STRIDE;
      const u16* g2 = (const u16*)m2;
#pragma unroll
      for (int i = 0; i < 6; ++i) LD[i] = *(const u32x4*)(g2 + (size_t)(i * 256 + tid) * 8);
#pragma unroll
      for (int i = 0; i < 2; ++i) { int q = i * 256 + tid; int r = q >> 3, c = q & 7; LD[6 + i] = *(const u32x4*)(vct + (size_t)r * SEQ + (n + 1) * 64 + c * 8); }
      if (tid < 80) LDV = *(const f32x4*)(m2 + 24576 + tid * 16);
    }
    unsigned orw[4][2];
#pragma unroll
    for (int j = 0; j < 4; ++j) {
      size_t row = (size_t)b * SEQ + n * 64 + 16 * wid + fq * 4 + j;
#pragma unroll
      for (int k = 0; k < 2; ++k)
        orw[j][k] = (unsigned)proj[row * PROJ_LD + 2816 + h * 64 + (2 * k) * 16 + fr] | ((unsigned)proj[row * PROJ_LD + 2816 + h * 64 + (2 * k + 1) * 16 + fr] << 16);
    }
    {
      int l_ = tid >> 2, part = tid & 3;
      float s = 0.f;
#pragma unroll
      for (int i = 0; i < 16; ++i) s += bf2f(QCs[l_ * 72 + part * 16 + i]) * nvec[part * 16 + i];
      s += __shfl_xor(s, 1); s += __shfl_xor(s, 2);
      if (part == 0) qn[l_] = s;
    }
    __syncthreads();
    float decay = vecs[256];
    f32x4 a1[4], a2[4];
#pragma unroll
    for (int i = 0; i < 4; ++i) { a1[i] = (f32x4){0.f, 0.f, 0.f, 0.f}; a2[i] = (f32x4){0.f, 0.f, 0.f, 0.f}; }
#pragma unroll
    for (int ks = 0; ks < 2; ++ks) {
      bf16x8 a = ldfrag72(QCs, 16 * wid + fr, ks, fq);
#pragma unroll
      for (int nt = 0; nt < 4; ++nt) a1[nt] = mfma16(a, ldfrag72(CTs, nt * 16 + fr, ks, fq), a1[nt]);
    }
#pragma unroll
    for (int ks = 0; ks < 2; ++ks) {
      bf16x8 a = ldfrag72(Ps, 16 * wid + fr, ks, fq);
#pragma unroll
      for (int nt = 0; nt < 4; ++nt) a2[nt] = mfma16(a, ldfrag72(VTs, nt * 16 + fr, ks, fq), a2[nt]);
    }
#pragma unroll
    for (int j = 0; j < 4; ++j) {
      int l_ = 16 * wid + fq * 4 + j;
      float ai = vecs[l_], en = vecs[64 + l_], rs = vecs[128 + l_];
      float den = ai * qn[l_] + rs;
      float dn = fmaxf(fabsf(den), en);
      float inv = 1.f / dn;
      size_t row = (size_t)b * SEQ + n * 64 + l_;
      float hv[4]; float s = 0.f;
#pragma unroll
      for (int nt = 0; nt < 4; ++nt) {
        size_t idx = row * PROJ_LD + 2816 + h * 64 + nt * 16 + fr;
        float og = sigmf(bf2f((u16)(orw[j][nt >> 1] >> ((nt & 1) * 16))));
        hv[nt] = (ai * a1[nt][j] + a2[nt][j]) * inv * og;
        s += hv[nt];
      }
      s = red16_sum(s);
      float mu = s * (1.f / 64.f);
      float q = 0.f;
#pragma unroll
      for (int nt = 0; nt < 4; ++nt) { float d = hv[nt] - mu; q += d * d; }
      q = red16_sum(q);
      float rstd = rsqrtf(q * (1.f / 64.f) + 1e-6f);
#pragma unroll
      for (int nt = 0; nt < 4; ++nt) {
        size_t idx = row * PROJ_LD + 2816 + h * 64 + nt * 16 + fr;
        proj[idx] = f2bf((hv[nt] - mu) * rstd * mnorm[nt * 16 + fr]);
      }
    }
#pragma unroll
    for (int nt = 0; nt < 4; ++nt) { ct[nt][0] *= decay; ct[nt][1] *= decay; ct[nt][2] *= decay; ct[nt][3] *= decay; }
#pragma unroll
    for (int ks = 0; ks < 2; ++ks) {
      bf16x8 a = ldfrag72(VTs, 16 * wid + fr, ks, fq);
#pragma unroll
      for (int nt = 0; nt < 4; ++nt) ct[nt] = mfma16(a, ldfrag72(SKs, nt * 16 + fr, ks, fq), ct[nt]);
    }
    float nnew = 0.f;
    if (tid < 64) nnew = decay * nvec[tid] + vecs[192 + tid];
    __syncthreads();
#pragma unroll
    for (int nt = 0; nt < 4; ++nt)
#pragma unroll
      for (int j = 0; j < 4; ++j) CTs[(16 * wid + fq * 4 + j) * 72 + nt * 16 + fr] = f2bf(ct[nt][j]);
    if (tid < 64) nvec[tid] = nnew;
    if (n + 1 < 128) {
#pragma unroll
      for (int i = 0; i < 6; ++i) { int q = i * 256 + tid; int mat = q >> 9, r = (q >> 3) & 63, c = q & 7; *(u32x4*)(QCs + mat * 64 * 72 + r * 72 + c * 8) = WR[i]; }
#pragma unroll
      for (int i = 0; i < 2; ++i) { int q = i * 256 + tid; int r = q >> 3, c = q & 7; *(u32x4*)(VTs + r * 72 + c * 8) = WR[6 + i]; }
      if (tid < 80) *(f32x4*)(vecs + tid * 4) = WRV;
    }
    __syncthreads();
  };
  for (int n = 0; n < 128; ++n) step(n, pre, prev, pre, prev);
}

__device__ __forceinline__ bool moba_next(int& blk, int& kt, int own, int nown, unsigned um) {
  ++kt;
  for (;;) {
    if (blk > own) return false;
    bool isown = (blk == own);
    bool sel = isown || ((um >> blk) & 1u);
    int ntile = isown ? nown : 4;
    if (sel && kt < ntile) return true;
    ++blk; kt = 0;
  }
}
__device__ void moba_item(const Params& p, int idx, unsigned char* smem) {
  int qt = 127 - (idx >> 4), bh = idx & 15, b = bh >> 2, h = bh & 3;
  int tid = get_tid(), wid = tid >> 6, lane = tid & 63, fr = lane & 15, fq = lane >> 4;
  int t0 = qt * 64, own = t0 >> 8;
  u16* KV = (u16*)smem;
  u16* Qs = KV + 4 * 64 * 72; u16* Ps = Qs + 64 * 72;
  float* km = (float*)(Ps + 64 * 72);
  float* gate = km + 32 * 64;
  unsigned* selm = (unsigned*)(gate + 64 * 33);
  unsigned* uni = selm + 64;
  u16* proj = (u16*)(p.ws + OFF_PROJ);
  const u16* vbt = (const u16*)(p.ws + OFF_VBT) + (size_t)bh * 64 * SEQ;
  const u16* kbase = proj + (size_t)b * SEQ * PROJ_LD + 1920 + h * 64;
  const float* kmean = (const float*)(p.ws + OFF_KMEAN) + (size_t)bh * 32 * 64;
  __syncthreads();
#pragma unroll
  for (int i = 0; i < 2; ++i) { int q = i * 256 + tid; int r = q >> 3, c = q & 7; *(u32x4*)(Qs + r * 72 + c * 8) = *(const u32x4*)(proj + ((size_t)b * SEQ + t0 + r) * PROJ_LD + 2560 + h * 64 + c * 8); }
  if (tid == 0) *uni = 0u;
  {
    const float* gm = (const float*)(p.ws + OFF_GM) + ((size_t)b * SEQ + t0) * 128 + h * 32;
    for (int i = tid; i < 64 * 32; i += NT) { int q = i >> 5, nb = i & 31; if (nb < own) gate[q * 33 + nb] = gm[(size_t)q * 128 + nb]; }
  }
  __syncthreads();
  if (tid < 64) {
    unsigned m = 0u;
    for (int r = 0; r < 3; ++r) {
      float best = -INFINITY; int bi = -1;
      for (int nb = 0; nb < own; ++nb) { float gv = gate[tid * 33 + nb]; if (!((m >> nb) & 1u) && gv > best) { best = gv; bi = nb; } }
      if (bi >= 0) m |= (1u << bi);
    }
    selm[tid] = m;
    if (m) atomicOr(uni, m);
  }
  __syncthreads();
  unsigned um = *uni;
  bf16x8 qf[2];
  qf[0] = ldfrag72(Qs, 16 * wid + fr, 0, fq); qf[1] = ldfrag72(Qs, 16 * wid + fr, 1, fq);
  unsigned mysel[4]; float mrun[4], lrun[4];
#pragma unroll
  for (int j = 0; j < 4; ++j) { mysel[j] = selm[16 * wid + fq * 4 + j]; mrun[j] = -INFINITY; lrun[j] = 0.f; }
  f32x4 o[4];
#pragma unroll
  for (int i = 0; i < 4; ++i) o[i] = (f32x4){0.f, 0.f, 0.f, 0.f};
  int nown = ((t0 - own * 256) >> 6) + 1;
  int blk = 0, kt = -1;
  bool have = moba_next(blk, kt, own, nown, um);
  u32x4 pk[2], pv[2];
  {
    int key0 = blk * 256 + kt * 64;
#pragma unroll
    for (int i = 0; i < 2; ++i) {
      int q = i * 256 + tid; int r = q >> 3, c = q & 7;
      pk[i] = *(const u32x4*)(kbase + (size_t)(key0 + r) * PROJ_LD + c * 8);
      pv[i] = *(const u32x4*)(vbt + (size_t)r * SEQ + key0 + c * 8);
    }
#pragma unroll
    for (int i = 0; i < 2; ++i) {
      int q = i * 256 + tid; int r = q >> 3, c = q & 7;
      *(u32x4*)(KV + r * 72 + c * 8) = pk[i];
      *(u32x4*)(KV + 64 * 72 + r * 72 + c * 8) = pv[i];
    }
  }
  __syncthreads();
  int it = 0;
  while (have) {
    int cblk = blk, ckt = kt;
    bool hn = moba_next(blk, kt, own, nown, um);
    if (hn) {
      int key0n = blk * 256 + kt * 64;
#pragma unroll
      for (int i = 0; i < 2; ++i) {
        int q = i * 256 + tid; int r = q >> 3, c = q & 7;
        pk[i] = *(const u32x4*)(kbase + (size_t)(key0n + r) * PROJ_LD + c * 8);
        pv[i] = *(const u32x4*)(vbt + (size_t)r * SEQ + key0n + c * 8);
      }
    }
    const u16* Ks = KV + (it & 1) * 2 * 64 * 72; const u16* Vts = Ks + 64 * 72;
    bool isown = (cblk == own);
    int key0 = cblk * 256 + ckt * 64;
    f32x4 s[4];
#pragma unroll
    for (int i = 0; i < 4; ++i) s[i] = (f32x4){0.f, 0.f, 0.f, 0.f};
#pragma unroll
    for (int ks = 0; ks < 2; ++ks)
#pragma unroll
      for (int nt = 0; nt < 4; ++nt) s[nt] = mfma16(qf[ks], ldfrag72(Ks, nt * 16 + fr, ks, fq), s[nt]);
#pragma unroll
    for (int j = 0; j < 4; ++j) {
      int qpos = t0 + 16 * wid + fq * 4 + j;
      bool rowok = isown ? true : (((mysel[j] >> cblk) & 1u) != 0u);
      float mx = -INFINITY;
#pragma unroll
      for (int nt = 0; nt < 4; ++nt) {
        int key = key0 + nt * 16 + fr;
        bool ok = isown ? (key <= qpos) : rowok;
        float v = ok ? s[nt][j] * 0.125f : -INFINITY;
        s[nt][j] = v; mx = fmaxf(mx, v);
      }
      mx = red16_max(mx);
      float mnew = fmaxf(mrun[j], mx);
      float msafe = (mnew == -INFINITY) ? 0.f : mnew;
      float sc = __expf(mrun[j] - msafe);
      float ps = 0.f;
#pragma unroll
      for (int nt = 0; nt < 4; ++nt) { float pe = __expf(s[nt][j] - msafe); ps += pe; s[nt][j] = pe; }
      ps = red16_sum(ps);
      lrun[j] = lrun[j] * sc + ps; mrun[j] = mnew;
#pragma unroll
      for (int nt = 0; nt < 4; ++nt) o[nt][j] *= sc;
    }
#pragma unroll
    for (int nt = 0; nt < 4; ++nt)
#pragma unroll
      for (int j = 0; j < 4; ++j) Ps[(16 * wid + fq * 4 + j) * 72 + nt * 16 + fr] = f2bf(s[nt][j]);
    asm volatile("s_waitcnt lgkmcnt(0)" ::: "memory");
#pragma unroll
    for (int ks = 0; ks < 2; ++ks) {
      bf16x8 a = ldfrag72(Ps, 16 * wid + fr, ks, fq);
#pragma unroll
      for (int nt = 0; nt < 4; ++nt) o[nt] = mfma16(a, ldfrag72(Vts, nt * 16 + fr, ks, fq), o[nt]);
    }
    if (hn) {
      u16* Kn = KV + ((it + 1) & 1) * 2 * 64 * 72;
#pragma unroll
      for (int i = 0; i < 2; ++i) {
        int q = i * 256 + tid; int r = q >> 3, c = q & 7;
        *(u32x4*)(Kn + r * 72 + c * 8) = pk[i];
        *(u32x4*)(Kn + 64 * 72 + r * 72 + c * 8) = pv[i];
      }
    }
    __syncthreads();
    have = hn; ++it;
  }
#pragma unroll
  for (int j = 0; j < 4; ++j) {
    float inv = 1.f / lrun[j];
    size_t row = (size_t)b * SEQ + t0 + 16 * wid + fq * 4 + j;
#pragma unroll
    for (int nt = 0; nt < 4; ++nt) proj[row * PROJ_LD + 2560 + h * 64 + nt * 16 + fr] = f2bf(o[nt][j] * inv);
  }
}

__device__ __forceinline__ void grid_barrier(unsigned* bar, unsigned target) {
  asm volatile("s_waitcnt vmcnt(0) lgkmcnt(0)" ::: "memory");
  __syncthreads();
  if (threadIdx.x == 0) {
    __builtin_amdgcn_fence(__ATOMIC_RELEASE, "agent");
    asm volatile("s_waitcnt vmcnt(0)" ::: "memory");
    __hip_atomic_fetch_add(bar, 1u, __ATOMIC_RELAXED, __HIP_MEMORY_SCOPE_AGENT);
    while (__hip_atomic_load(bar, __ATOMIC_RELAXED, __HIP_MEMORY_SCOPE_AGENT) < target) __builtin_amdgcn_s_sleep(2);
    __builtin_amdgcn_fence(__ATOMIC_ACQUIRE, "agent");
    asm volatile("s_waitcnt vmcnt(0)" ::: "memory");
  }
  __syncthreads();
  asm volatile("buffer_inv sc1\n\ts_waitcnt vmcnt(0)" ::: "memory");
}

__global__ void __launch_bounds__(NT, 2) fwd_megakernel(Params p) {
  __shared__ __attribute__((aligned(16))) unsigned char smem[SMEM_BYTES];
  cg::grid_group grid = cg::this_grid();
  int* ctr = (int*)(p.ws + OFF_CTR);
  u16* wt = (u16*)(p.ws + OFF_WT);
  u16* Abuf = (u16*)(p.ws + OFF_GDNI);
  u16* hbuf = (u16*)(p.ws + OFF_PROJ);
  int ph = 0;
#define PH_BEGIN if (ph >= p.ph_lo && ph < p.ph_hi) {
#define PH_END } ++ph; if (p.coop && ph > p.ph_lo && ph < p.ph_hi) { grid_barrier(gbar, (unsigned)(ph - p.ph_lo) * gridDim.x); }
  unsigned* gbar = (unsigned*)(p.ws + OFF_CTR) + 1024;
  if (p.coop) grid.sync();
  PH_BEGIN
    for (int it = blockIdx.x; it < 576 + NCONV_ITEMS; it += gridDim.x) {
      if (it < 576) modp_item(p, it, smem); else convert_item(p, 0, it - 576, smem);
    }
  PH_END
  PH_BEGIN
    mod_finalize(p);
  PH_END
  PH_BEGIN
    ln_phase(p, false, 0, 0, true, 0, 0);
  PH_END
  for (int l0 = 0; l0 < 2; ++l0) {
    int l = l0; asm volatile("" : "+s"(l));
    EpiArgs ea;
    PH_BEGIN
      ea.xres = nullptr; ea.l = l; ea.sub = 0; ea.gs = 0.f;
      gemm_phase<EPI_SWIGLU>(p, Abuf, DM, wt + WT13_OFF(0), 1024, 44, ea, smem, -1, true);
    PH_END
    PH_BEGIN
      ea.xres = (l == 0) ? p.x : p.out; ea.l = l; ea.sub = 0; ea.gs = 0.5f;
      gemm_phase<EPI_RES>(p, hbuf, DFF, wt + WT2_OFF(0), 2816, 8, ea, smem);
    PH_END
    PH_BEGIN
      ln_phase(p, true, l, 0, true, l, 1);
    PH_END
    PH_BEGIN
      for (int it = blockIdx.x; it < 512; it += gridDim.x) u_item(p, l, it, smem);
    PH_END
    PH_BEGIN
      ea.xres = nullptr; ea.l = l; ea.sub = 1; ea.gs = 0.f;
      gemm_phase<EPI_PROJ>(p, Abuf, DM, wt + WTIN_OFF, 1024, 31, ea, smem, -1, true);
      gemm_phase<EPI_PROJ>(p, Abuf, DM, wt + WTIN_OFF, 1024, 31, ea, smem, 31);
      { float* xbz = (float*)(p.ws + OFF_XBAR);
        for (int i = blockIdx.x * NT + get_tid(); i < 128 * 1024; i += gridDim.x * NT) xbz[i] = 0.f; }
    PH_END
    PH_BEGIN
      int* c = ctr + (l * 3 + 0) * 16;
      for (;;) {
        int it = next_item(c);
        if (it >= 24 + 3072 + 3072) break;
        if (it < 24) mchain_item(p, l, it, smem);
        else if (it < 3096) gdn_local_item(p, l, it - 24, smem);
        else mlstm_local_item(p, l, it - 3096, smem);
      }
    PH_END
    PH_BEGIN
      int* c = ctr + (l * 3 + 1) * 16;
      if (blockIdx.x < 24) { __builtin_amdgcn_s_setprio(3); gdn_scan_item(p, l, blockIdx.x, smem); __builtin_amdgcn_s_setprio(0); }
      else if (blockIdx.x < 48) { __builtin_amdgcn_s_setprio(3); mlstm_scan_item(p, l, blockIdx.x - 24, smem); __builtin_amdgcn_s_setprio(0); }
      if (!(gridDim.x == 512 && blockIdx.x >= 256 && blockIdx.x < 304))
      for (;;) {
        int it = next_item(c);
        if (it >= 2048) break;
        moba_item(p, it, smem);
      }
    PH_END
    PH_BEGIN
      ea.xres = p.out; ea.l = l; ea.sub = 1; ea.gs = 1.0f;
      gemm_phase<EPI_RES>(p, hbuf + 2176, PROJ_LD, wt + WTOUT_OFF, 1024, 8, ea, smem);
    PH_END
    PH_BEGIN
      ln_phase(p, true, l, 1, true, l, 2);
    PH_END
    PH_BEGIN
      ea.xres = nullptr; ea.l = l; ea.sub = 2; ea.gs = 0.f;
      gemm_phase<EPI_SWIGLU>(p, Abuf, DM, wt + WT13_OFF(1), 1024, 44, ea, smem, -1, true);
    PH_END
    PH_BEGIN
      ea.xres = p.out; ea.l = l; ea.sub = 2; ea.gs = 0.5f;
      gemm_phase<EPI_RES>(p, hbuf, DFF, wt + WT2_OFF(1), 2816, 8, ea, smem);
    PH_END
    PH_BEGIN
      ln_phase(p, true, l, 2, l == 0, 1, 0);
      if (l == 0) for (int it = blockIdx.x; it < NCONV_ITEMS; it += gridDim.x) convert_item(p, 1, it, smem);
    PH_END
  }
}

#define N_PHASES 27

extern "C" void kernel_launch(void* const* d_in, const int* in_sizes, int n_in, void* d_out, int out_size,
                              void* d_ws, size_t ws_size, hipStream_t stream) {
  static int grid_blocks = 0;
  if (!grid_blocks) {
    int dev = 0, cus = 0, per_cu = 0;
    hipGetDevice(&dev);
    hipDeviceGetAttribute(&cus, hipDeviceAttributeMultiprocessorCount, dev);
    hipOccupancyMaxActiveBlocksPerMultiprocessor(&per_cu, fwd_megakernel, NT, 0);
    if (per_cu > 2) per_cu = 2;
    if (per_cu < 1) per_cu = 1;
    grid_blocks = cus * per_cu;
  }
  if (ws_size < WS_NEEDED) { fprintf(stderr, "workspace too small: %zu\n", ws_size); return; }
  Params p{};
  const float** f = (const float**)d_in;
  p.x = f[0]; p.c = f[1]; p.ada_w = f[2]; p.ada_b = f[3]; p.w13 = f[4]; p.w2 = f[5]; p.w_in = f[6]; p.w_out = f[7];
  p.gdn_conv = f[8]; p.gdn_a_log = f[9]; p.gdn_dt_bias = f[10]; p.gdn_norm = f[11]; p.mlstm_conv = f[12];
  p.mlstm_i_bias = f[13]; p.mlstm_f_bias = f[14]; p.mlstm_norm = f[15]; p.ln_g = f[16]; p.ln_b = f[17];
  p.out = (float*)d_out; p.ws = (unsigned char*)d_ws;
  p.ph_lo = 0; p.ph_hi = N_PHASES; p.coop = 1; p.pad = 0;
  hipMemsetAsync((unsigned char*)d_ws + OFF_CTR, 0, 128 * 1024 + 512 * 1024, stream);
  void* args[] = {&p};
  hipError_t e = hipLaunchCooperativeKernel((void*)fwd_megakernel, dim3(grid_blocks), dim3(NT), args, 0, stream);
  if (e != hipSuccess) fprintf(stderr, "cooperative launch failed: %s (grid %d)\n", hipGetErrorString(e), grid_blocks);
}
```
